# Optimizing an MI355X kernel written in HIP

```python
import math
import jax, jax.numpy as jnp
from jax import lax
import numpy as np

D_MODEL = 1024
BATCH = 2
SEQ = 8192
DEPTH = 2

N_A_LAYERS = (DEPTH + 1) // 2
N_B_LAYERS = DEPTH // 2
DEEPNORM_ALPHA = (2.0 * DEPTH) ** 0.25
DEEPNORM_BETA = (8.0 * DEPTH) ** -0.25
LN_EPS = 1e-5
RMS_EPS = 1e-5

GLA_HEADS = 4
GLA_DK_TOTAL = D_MODEL // 2
GLA_DV_TOTAL = D_MODEL
GLA_DK = GLA_DK_TOTAL // GLA_HEADS
GLA_DV = GLA_DV_TOTAL // GLA_HEADS
GLA_GATE_RANK = 16
GLA_GATE_TAU = 16.0
GLA_CHUNK = 64
GLA_IN = 2 * GLA_DK_TOTAL + 2 * GLA_DV_TOTAL + GLA_GATE_RANK

SWA_GROUPS = ((128, 1), (512, 4), (2048, 16))
SWA_N_GROUPS = len(SWA_GROUPS)
SWA_HEAD_DIM = 128
SWA_Q_HEADS = 8
SWA_KV_HEADS = 2
SWA_REP = SWA_Q_HEADS // SWA_KV_HEADS
SWA_OUT = SWA_Q_HEADS * SWA_HEAD_DIM
SWA_Q_TOTAL = SWA_N_GROUPS * SWA_OUT
SWA_IN = SWA_Q_TOTAL + SWA_OUT
SWA_KV_HALF = SWA_N_GROUPS * SWA_KV_HEADS * SWA_HEAD_DIM
SWA_KV_TOTAL = 2 * SWA_KV_HALF
SWA_BLOCK = 128
ROPE_THETA = 10000.0

kernel_name = "yoco_gla_dilated_window_hybrid"


def layer_norm(x, g, b):
    x32 = x.astype(jnp.float32)
    mu = jnp.mean(x32, axis=-1, keepdims=True)
    xc = x32 - mu
    var = jnp.mean(xc * xc, axis=-1, keepdims=True)
    return (xc * lax.rsqrt(var + LN_EPS) * g.astype(jnp.float32) + b.astype(jnp.float32)).astype(x.dtype)


def rope(x, pos):
    e = x.shape[-1]
    half = e // 2
    inv = ROPE_THETA ** (-(jnp.arange(half, dtype=jnp.float32) * 2.0) / e)
    ang = pos.astype(jnp.float32)[:, None] * inv[None, :]
    cos = jnp.cos(ang)[None, :, None, :]
    sin = jnp.sin(ang)[None, :, None, :]
    x32 = x.astype(jnp.float32)
    x1, x2 = x32[..., :half], x32[..., half:]
    return jnp.concatenate([x1 * cos - x2 * sin, x2 * cos + x1 * sin], axis=-1)


def gla_chunked(q, k, v, log_a):
    bsz, s, h, dk = q.shape
    dv = v.shape[-1]
    c = GLA_CHUNK
    n = s // c

    def to_chunks(t):
        return t.reshape(bsz, n, c, h, t.shape[-1]).transpose(1, 0, 3, 2, 4)

    qc_all, kc_all, vc_all = to_chunks(q), to_chunks(k), to_chunks(v)
    b_all = jnp.cumsum(to_chunks(log_a), axis=3)
    causal = jnp.tril(jnp.ones((c, c), dtype=bool))[None, None, :, :, None]

    def step(state, inp):
        qc, kc, vc, bc = inp
        o_inter = jnp.einsum('bhcd,bhde->bhce', qc * jnp.exp(bc), state)
        diff = bc[:, :, :, None, :] - bc[:, :, None, :, :]
        decay = jnp.where(causal, jnp.exp(jnp.where(causal, diff, 0.0)), 0.0)
        att = jnp.einsum('bhid,bhjd,bhijd->bhij', qc, kc, decay)
        o_intra = jnp.einsum('bhij,bhje->bhie', att, vc)
        b_last = bc[:, :, -1:, :]
        new_state = jnp.exp(b_last[:, :, 0, :])[..., None] * state + \
            jnp.einsum('bhcd,bhce->bhde', kc * jnp.exp(b_last - bc), vc)
        return new_state, o_inter + o_intra

    state0 = jnp.zeros((bsz, h, dk, dv), dtype=jnp.float32)
    _, o = lax.scan(step, state0, (qc_all, kc_all, vc_all, b_all))
    return o.transpose(1, 0, 3, 2, 4).reshape(bsz, s, h, dv)


def gla_mixer(x, w_in, w_a2, b_a2, norm_g, w_out):
    bsz, s, _ = x.shape
    proj = x @ w_in
    q, k, v, g, a_lr = jnp.split(
        proj, [GLA_DK_TOTAL, 2 * GLA_DK_TOTAL, 2 * GLA_DK_TOTAL + GLA_DV_TOTAL,
               2 * GLA_DK_TOTAL + 2 * GLA_DV_TOTAL], axis=-1)
    q = q.astype(jnp.float32).reshape(bsz, s, GLA_HEADS, GLA_DK) * (GLA_DK ** -0.5)
    k = k.astype(jnp.float32).reshape(bsz, s, GLA_HEADS, GLA_DK)
    v = v.astype(jnp.float32).reshape(bsz, s, GLA_HEADS, GLA_DV)
    log_a = jax.nn.log_sigmoid((a_lr @ w_a2 + b_a2).astype(jnp.float32)) / GLA_GATE_TAU
    log_a = log_a.reshape(bsz, s, GLA_HEADS, GLA_DK)
    o = gla_chunked(q, k, v, log_a)
    o = o * lax.rsqrt(jnp.mean(o * o, axis=-1, keepdims=True) + RMS_EPS)
    o = o.reshape(bsz, s, GLA_DV_TOTAL) * norm_g.astype(jnp.float32)
    return (o.astype(x.dtype) * jax.nn.silu(g)) @ w_out


def shared_kv(x, w_kv):
    bsz, s, _ = x.shape
    pos = jnp.arange(s)
    kv = x @ w_kv
    k, v = jnp.split(kv, [SWA_KV_HALF], axis=-1)
    k = rope(k.reshape(bsz, s, SWA_N_GROUPS * SWA_KV_HEADS, SWA_HEAD_DIM), pos)
    k = k.reshape(bsz, s, SWA_N_GROUPS, SWA_KV_HEADS, SWA_HEAD_DIM)
    v = v.astype(jnp.float32).reshape(bsz, s, SWA_N_GROUPS, SWA_KV_HEADS, SWA_HEAD_DIM)
    return k, v


def dilated_window_attention(q, k, v, window, dilation):
    bsz, s, hq, e = q.shape
    hkv = k.shape[2]
    rep = hq // hkv
    blk = SWA_BLOCK
    w_sub = window // dilation
    span = dilation * blk
    seq_pad = -(-s // span) * span
    n_sub = seq_pad // dilation
    nb = n_sub // blk

    def to_strided(t):
        t = jnp.pad(t, ((0, 0), (0, seq_pad - s), (0, 0), (0, 0)))
        t = t.reshape(bsz, n_sub, dilation, t.shape[2], e).transpose(0, 2, 1, 3, 4)
        return t.reshape(bsz, dilation, nb, blk, t.shape[3], e)

    qb = to_strided(q).reshape(bsz, dilation, nb, blk, hkv, rep, e)
    kb, vb = to_strided(k), to_strided(v)

    def with_prev(t):
        prev = jnp.pad(t, ((0, 0), (0, 0), (1, 0), (0, 0), (0, 0), (0, 0)))[:, :, :-1]
        return jnp.concatenate([prev, t], axis=3)

    kcat, vcat = with_prev(kb), with_prev(vb)
    scores = jnp.einsum('brnqgpe,brnkge->brngpqk', qb, kcat)
    qi = jnp.arange(blk)[:, None]
    kj = jnp.arange(2 * blk)[None, :]
    rel = blk + qi - kj
    band = (rel >= 0) & (rel <= w_sub)
    mask = band[None] & ((jnp.arange(nb)[:, None, None] > 0) | (kj[None] >= blk))
    scores = jnp.where(mask[None, None, :, None, None], scores, -jnp.inf)
    m = jnp.max(scores, axis=-1, keepdims=True)
    p = jnp.exp(scores - m)
    den = jnp.sum(p, axis=-1)
    o = jnp.einsum('brngpqk,brnkge->brnqgpe', p, vcat) / jnp.moveaxis(den, -1, 3)[..., None]
    lse = jnp.moveaxis(m[..., 0] + jnp.log(den), -1, 3)

    def from_strided(t):
        t = t.reshape((bsz, dilation, n_sub) + t.shape[6 - 2 + 1:] if False else (bsz, dilation, n_sub, -1))
        return t

    o = o.reshape(bsz, dilation, n_sub, hq, e).transpose(0, 2, 1, 3, 4).reshape(bsz, seq_pad, hq, e)[:, :s]
    lse = lse.reshape(bsz, dilation, n_sub, hq).transpose(0, 2, 1, 3).reshape(bsz, seq_pad, hq)[:, :s]
    return o, lse


def dilated_mixer(x, w_in, w_out, k_sh, v_sh):
    bsz, s, _ = x.shape
    pos = jnp.arange(s)
    proj = x @ w_in
    q, g = jnp.split(proj, [SWA_Q_TOTAL], axis=-1)
    q = rope(q.reshape(bsz, s, SWA_N_GROUPS * SWA_Q_HEADS, SWA_HEAD_DIM), pos) * (SWA_HEAD_DIM ** -0.5)
    q = q.reshape(bsz, s, SWA_N_GROUPS, SWA_Q_HEADS, SWA_HEAD_DIM)
    outs, lses = [], []
    for gi, (window, dilation) in enumerate(SWA_GROUPS):
        o_g, lse_g = dilated_window_attention(q[:, :, gi], k_sh[:, :, gi], v_sh[:, :, gi], window, dilation)
        outs.append(o_g)
        lses.append(lse_g)
    wts = jax.nn.softmax(jnp.stack(lses, axis=0), axis=0)
    o = jnp.sum(wts[..., None] * jnp.stack(outs, axis=0), axis=0)
    o = o.reshape(bsz, s, SWA_OUT)
    return (o.astype(x.dtype) * jax.nn.silu(g)) @ w_out


def setup_inputs(seed: int = 0) -> dict:
    key = jax.random.key(seed)
    ks = jax.random.split(key, 12)
    f32 = jnp.float32
    x = jax.random.normal(ks[0], (BATCH, SEQ, D_MODEL), f32)
    gla_w_in = jax.random.normal(ks[1], (N_A_LAYERS, D_MODEL, GLA_IN), f32) * D_MODEL ** -0.5
    gla_w_a2 = jax.random.normal(ks[2], (N_A_LAYERS, GLA_GATE_RANK, GLA_DK_TOTAL), f32) * GLA_GATE_RANK ** -0.5
    gla_b_a2 = jax.random.normal(ks[3], (N_A_LAYERS, GLA_DK_TOTAL), f32) * 0.1
    gla_norm_g = 1.0 + 0.02 * jax.random.normal(ks[4], (N_A_LAYERS, GLA_DV_TOTAL), f32)
    gla_w_out = jax.random.normal(ks[5], (N_A_LAYERS, GLA_DV_TOTAL, D_MODEL), f32) * (GLA_DV_TOTAL ** -0.5 * DEEPNORM_BETA)
    w_kv = jax.random.normal(ks[6], (D_MODEL, SWA_KV_TOTAL), f32) * D_MODEL ** -0.5
    swa_w_in = jax.random.normal(ks[7], (N_B_LAYERS, D_MODEL, SWA_IN), f32) * D_MODEL ** -0.5
    swa_w_out = jax.random.normal(ks[8], (N_B_LAYERS, SWA_OUT, D_MODEL), f32) * (SWA_OUT ** -0.5 * DEEPNORM_BETA)
    ln_g = 1.0 + 0.02 * jax.random.normal(ks[9], (DEPTH, D_MODEL), f32)
    ln_b = 0.02 * jax.random.normal(ks[10], (DEPTH, D_MODEL), f32)
    return {"x": x, "gla_w_in": gla_w_in, "gla_w_a2": gla_w_a2, "gla_b_a2": gla_b_a2,
            "gla_norm_g": gla_norm_g, "gla_w_out": gla_w_out, "w_kv": w_kv,
            "swa_w_in": swa_w_in, "swa_w_out": swa_w_out, "ln_g": ln_g, "ln_b": ln_b}


def reference(x, gla_w_in, gla_w_a2, gla_b_a2, gla_norm_g, gla_w_out, w_kv,
              swa_w_in, swa_w_out, ln_g, ln_b):
    k_sh = None
    v_sh = None
    for layer in range(DEPTH):
        if layer < N_A_LAYERS:
            y = gla_mixer(x, gla_w_in[layer], gla_w_a2[layer], gla_b_a2[layer],
                          gla_norm_g[layer], gla_w_out[layer])
        else:
            if layer == N_A_LAYERS:
                k_sh, v_sh = shared_kv(x, w_kv)
            i = layer - N_A_LAYERS
            y = dilated_mixer(x, swa_w_in[i], swa_w_out[i], k_sh, v_sh)
        x = layer_norm(DEEPNORM_ALPHA * x + y, ln_g[layer], ln_b[layer])
    return x
```

```cpp
#include <hip/hip_runtime.h>
#include <hip/hip_cooperative_groups.h>
#include <cstdio>
#include <cstdint>
#include <cstring>
#include <cmath>
namespace cg = cooperative_groups;
namespace pg8 {
#define PG8_LAS __attribute__((address_space(3)))
typedef unsigned short bf16_t;
typedef short bf16x8 __attribute__((ext_vector_type(8)));
typedef float f32x4 __attribute__((ext_vector_type(4)));
typedef unsigned u32x4 __attribute__((ext_vector_type(4)));
constexpr int BM = 256, BK = 64, HALF = 128, HTB = HALF * BK * 2  , STAGE_BYTES = 8 * HTB, NXCD = 8, WGM = 8;

__host__ __device__ __forceinline__ int lds_byte(int r, int c) { const int st = (r >> 4) * 2 + (c >> 5), rr = r & 15, cc = c & 31, ob = rr * 64 + cc * 2; return st * 1024 + (ob ^ (((ob >> 9) & 1) << 5)); }
__host__ __device__ __forceinline__ void stage_rc(int b, int& R, int& C) { const int st = b / 1024, sb = b % 1024, swz = sb ^ (((sb >> 9) & 1) << 5); R = (st >> 1) * 16 + swz / 64; C = (st & 1) * 32 + (swz % 64) / 2; }
__host__ __device__ __forceinline__ int perm32(int rho) { const int n = rho >> 4, i = rho & 15; return 8 * (i >> 2) + 4 * n + (i & 3); }

struct Unit { int pm, pn; };
struct Gemm { const bf16_t* A; const bf16_t* Bt; int M, N, K; };

struct StaticOrder {
    int nM, nN, nwg, G, c;
    __host__ __device__ void init(int M, int N, int G_, int c_) { nM = M / BM; nN = N / BM; nwg = nM * nN; G = G_; c = c_; }
    __host__ __device__ bool next(int i, Unit& u) const {
        const long L = (long)i * G + c; if (L >= nwg) return false;
        int wgid = (int)L; { const int q = nwg / NXCD, r = nwg % NXCD, xcd = wgid % NXCD, off = wgid / NXCD; wgid = (xcd < r ? xcd * (q + 1) : r * (q + 1) + (xcd - r) * q) + off; }
        const int nig = WGM * nN, gid = wgid / nig, fm = gid * WGM, gsz = (nM - fm) < WGM ? (nM - fm) : WGM;
        u.pm = fm + ((wgid % nig) % gsz); u.pn = (wgid % nig) / gsz; return true;
    }
    __device__ __forceinline__ void a_ready(const Unit&) const {}
    __device__ __forceinline__ void done(const Unit&) const {}
};
__device__ __forceinline__ unsigned cvt_pk_bf16(float lo, float hi) { unsigned r; asm volatile("v_cvt_pk_bf16_f32 %0, %1, %2" : "=v"(r) : "v"(lo), "v"(hi)); return r; }
typedef unsigned u32x2 __attribute__((ext_vector_type(2)));
struct EpiGla1 {
    static constexpr bool PERM = true, AFTER_DRAIN = false;
    bf16_t* O; float qscale;
    __device__ __forceinline__ void operator()(const f32x4 (&acc)[2][2][4][2], const Unit& u, int wr, int wc, int fr, int fq) const {
        const int row0 = u.pm * BM + wr * 64 + fr, col0 = u.pn * BM + wc * 32 + 8 * fq;
        const float sc = (u.pn < 2) ? qscale : 1.f;
#pragma unroll
        for (int ai = 0; ai < 2; ++ai)
#pragma unroll
            for (int m = 0; m < 4; ++m) { bf16_t* rowp = O + (size_t)(row0 + ai * HALF + m * 16) * 3072 + col0;
#pragma unroll
                for (int bj = 0; bj < 2; ++bj) { const f32x4 v0 = acc[ai][bj][m][0] * sc, v1 = acc[ai][bj][m][1] * sc;
                    u32x4 w; w.x = cvt_pk_bf16(v0[0], v0[1]); w.y = cvt_pk_bf16(v0[2], v0[3]); w.z = cvt_pk_bf16(v1[0], v1[1]); w.w = cvt_pk_bf16(v1[2], v1[3]);
                    *(u32x4*)(rowp + bj * HALF) = w; } }
    }
};
struct EpiResid {
    static constexpr bool PERM = false, AFTER_DRAIN = false;
    const float* resid; float* V; float alpha;
    __device__ __forceinline__ void operator()(const f32x4 (&acc)[2][2][4][2], const Unit& u, int wr, int wc, int fr, int fq) const {
        const int row0 = u.pm * BM + wr * 64 + fr, col0 = u.pn * BM + wc * 32 + 4 * fq;
#pragma unroll
        for (int ai = 0; ai < 2; ++ai)
#pragma unroll
            for (int m = 0; m < 4; ++m) { const size_t off = (size_t)(row0 + ai * HALF + m * 16) * 1024 + col0;
#pragma unroll
                for (int bj = 0; bj < 2; ++bj)
#pragma unroll
                    for (int n = 0; n < 2; ++n) { const f32x4 rs = *(const f32x4*)(resid + off + bj * HALF + n * 16);
                        *(f32x4*)(V + off + bj * HALF + n * 16) = rs * alpha + acc[ai][bj][m][n]; } }
    }
};
struct EpiRope {
    static constexpr bool PERM = true, AFTER_DRAIN = false;
    bf16_t *Kb, *Vb, *Qb, *Gb; const float* cosT; const float* sinT; float qscale;
    __device__ __forceinline__ void operator()(const f32x4 (&acc)[2][2][4][2], const Unit& u, int wr, int wc, int fr, int fq) const {
        const int row0 = u.pm * BM + wr * 64 + fr;
        const int pn = u.pn;
        const bool rope = (pn < 3) || (pn >= 6 && pn < 18);
        bf16_t* base; int ld, ct; float sc = 1.f;
        if (pn < 3) { base = Kb; ld = 768; ct = pn * BM; }
        else if (pn < 6) { base = Vb; ld = 768; ct = (pn - 3) * BM; }
        else if (pn < 18) { base = Qb; ld = 3072; ct = (pn - 6) * BM; sc = qscale; }
        else { base = Gb; ld = 1024; ct = (pn - 18) * BM; }
        if (rope) {
            const int i0 = 4 * (4 * wc + fq);
#pragma unroll
            for (int ai = 0; ai < 2; ++ai)
#pragma unroll
                for (int m = 0; m < 4; ++m) { const int row = row0 + ai * HALF + m * 16; const int pos = row & 8191;
                    const f32x4 c = *(const f32x4*)(cosT + pos * 64 + i0) * sc, s = *(const f32x4*)(sinT + pos * 64 + i0) * sc;
                    bf16_t* rowp = base + (size_t)row * ld + ct + i0;
#pragma unroll
                    for (int bj = 0; bj < 2; ++bj) { const f32x4 x1 = acc[ai][bj][m][0], x2 = acc[ai][bj][m][1];
                        const f32x4 o1 = x1 * c - x2 * s, o2 = x2 * c + x1 * s;
                        u32x2 w1, w2; w1.x = cvt_pk_bf16(o1[0], o1[1]); w1.y = cvt_pk_bf16(o1[2], o1[3]); w2.x = cvt_pk_bf16(o2[0], o2[1]); w2.y = cvt_pk_bf16(o2[2], o2[3]);
                        *(u32x2*)(rowp + bj * HALF) = w1; *(u32x2*)(rowp + bj * HALF + 64) = w2; } }
        } else {
            const int col0 = ct + wc * 32 + 8 * fq;
#pragma unroll
            for (int ai = 0; ai < 2; ++ai)
#pragma unroll
                for (int m = 0; m < 4; ++m) { bf16_t* rowp = base + (size_t)(row0 + ai * HALF + m * 16) * ld + col0;
#pragma unroll
                    for (int bj = 0; bj < 2; ++bj) { const f32x4 v0 = acc[ai][bj][m][0], v1 = acc[ai][bj][m][1];
                        u32x4 w; w.x = cvt_pk_bf16(v0[0], v0[1]); w.y = cvt_pk_bf16(v0[2], v0[3]); w.z = cvt_pk_bf16(v1[0], v1[1]); w.w = cvt_pk_bf16(v1[2], v1[3]);
                        *(u32x4*)(rowp + bj * HALF) = w; } }
        }
    }
};

template <class Epi, class Sched, bool ALIGN_EPI = false, bool SP2 = false>
__device__ __forceinline__ void gemm_phase(PG8_LAS unsigned char* lds, const Gemm g, const Sched& S, const Epi& E) {
    const int tid = threadIdx.x, wid = __builtin_amdgcn_readfirstlane(tid >> 6), lane = tid & 63, wr = wid >> 2, wc = wid & 3, fr = lane & 15, fq = lane >> 4;
    const int K = g.K, nt = K / BK;
    unsigned voffA[2], voffB[2];
#pragma unroll
    for (int i = 0; i < 2; ++i) { int R, C; stage_rc(tid * 16 + i * 8192, R, C); const int Rb = Epi::PERM ? ((R & ~31) + perm32(R & 31)) : R;
        voffA[i] = (unsigned)(R * K + C) * 2u; voffB[i] = (unsigned)(Rb * K + C) * 2u; }
    const size_t kstep = (size_t)(BK * 2);
    const size_t hstep = (size_t)HALF * K * 2;
    const size_t tstep = 2 * hstep;
    const unsigned ldsw = (unsigned)wid * 1024u;
    const int aoff = lds_byte(wr * 64 + fr, fq * 8), boff = lds_byte(wc * 32 + fr, fq * 8);
#define PG8_SA(b, h) (((b) * 2 + (h)) * HTB)
#define PG8_SB(b, h) ((4 + (b) * 2 + (h)) * HTB)
#define PG8_STAGE(bufoff, gbase, voff) do { _Pragma("unroll") for (int _i = 0; _i < 2; ++_i) \
        __builtin_amdgcn_global_load_lds((const unsigned*)((const char*)(gbase) + (voff)[_i]), (PG8_LAS unsigned*)(lds + (bufoff) + ldsw + _i * 8192), 16, 0, 0); } while (0)
#define PG8_LDA(dst, b, h) do { _Pragma("unroll") for (int m = 0; m < 4; ++m) _Pragma("unroll") for (int k = 0; k < 2; ++k) dst[m][k] = *(const PG8_LAS bf16x8*)(lds + PG8_SA(b, h) + aoff + m * 2048 + k * 1024); } while (0)
#define PG8_LDB(dst, b, h) do { _Pragma("unroll") for (int n = 0; n < 2; ++n) _Pragma("unroll") for (int k = 0; k < 2; ++k) dst[n][k] = *(const PG8_LAS bf16x8*)(lds + PG8_SB(b, h) + boff + n * 2048 + k * 1024); } while (0)
#define PG8_MMA(ai, bj, At, Bt) do { __builtin_amdgcn_s_setprio(1); _Pragma("unroll") for (int m = 0; m < 4; ++m) _Pragma("unroll") for (int n = 0; n < 2; ++n) _Pragma("unroll") for (int k = 0; k < 2; ++k) \
        acc[ai][bj][m][n] = __builtin_amdgcn_mfma_f32_16x16x32_bf16(Bt[n][k], At[m][k], acc[ai][bj][m][n], 0, 0, 0); __builtin_amdgcn_s_setprio(0); } while (0)
#define PG8_WAIT_V(n) asm volatile("s_waitcnt vmcnt(" #n ")" ::: "memory")
#define PG8_WAIT_L(n) asm volatile("s_waitcnt lgkmcnt(" #n ")" ::: "memory")
#define PG8_BAR __builtin_amdgcn_s_barrier()
#define PG8_SCHED __builtin_amdgcn_sched_barrier(0)
    Unit cur, nxt; int ui = 0;
    if (!S.next(0, cur)) return;
    f32x4 acc[2][2][4][2];
#pragma unroll
    for (int a = 0; a < 2; ++a)
#pragma unroll
        for (int b = 0; b < 2; ++b)
#pragma unroll
            for (int m = 0; m < 4; ++m)
#pragma unroll
                for (int n = 0; n < 2; ++n) acc[a][b][m][n] = (f32x4){0.f, 0.f, 0.f, 0.f};
    bf16x8 At[4][2], B0[2][2], B1[2][2];
    const char* cA = (const char*)g.A + (size_t)cur.pm * tstep; const char* cB = (const char*)g.Bt + (size_t)cur.pn * tstep;
    S.a_ready(cur);
    if constexpr (SP2) {
        PG8_STAGE(PG8_SB(0, 0), cB, voffB); PG8_STAGE(PG8_SB(0, 1), cB + hstep, voffB); PG8_STAGE(PG8_SA(0, 0), cA, voffA); PG8_STAGE(PG8_SA(0, 1), cA + hstep, voffA);
        if (wr == 1) PG8_BAR;
        PG8_WAIT_V(2); PG8_BAR;
        PG8_STAGE(PG8_SB(1, 0), cB + kstep, voffB); PG8_STAGE(PG8_SA(1, 0), cA + kstep, voffA); PG8_STAGE(PG8_SB(1, 1), cB + hstep + kstep, voffB);
        PG8_WAIT_V(6); PG8_BAR;
    } else {
        PG8_STAGE(PG8_SB(0, 0), cB, voffB); PG8_STAGE(PG8_SA(0, 0), cA, voffA); PG8_STAGE(PG8_SB(0, 1), cB + hstep, voffB); PG8_STAGE(PG8_SA(0, 1), cA + hstep, voffA);
        if (wr == 1) PG8_BAR;
        PG8_WAIT_V(4); PG8_BAR;
        PG8_STAGE(PG8_SB(1, 0), cB + kstep, voffB); PG8_STAGE(PG8_SA(1, 0), cA + kstep, voffA); PG8_STAGE(PG8_SB(1, 1), cB + hstep + kstep, voffB);
        PG8_WAIT_V(6); PG8_BAR;
    }
    for (;;) {
        const bool has_next = S.next(ui + 1, nxt);
        const char* nA = has_next ? (const char*)g.A + (size_t)nxt.pm * tstep : cA; const char* nB = has_next ? (const char*)g.Bt + (size_t)nxt.pn * tstep : cB;
        for (int t = 0; t < nt; t += 2) {
            const bool last = (t == nt - 2);
            const char* a1 = cA + (size_t)(t + 1) * kstep;
            const char* a2 = last ? nA : cA + (size_t)(t + 2) * kstep; const char* b2 = last ? nB : cB + (size_t)(t + 2) * kstep;
            const char* a3 = a2 + kstep; const char* b3 = b2 + kstep;
            if (last && has_next) S.a_ready(nxt);
            if constexpr (SP2) {
            PG8_LDB(B0, 0, 0); PG8_LDB(B1, 0, 1); PG8_SCHED; PG8_LDA(At, 0, 0); PG8_STAGE(PG8_SA(1, 1), a1 + hstep, voffA);
            PG8_WAIT_V(8); PG8_WAIT_L(0); PG8_BAR; PG8_MMA(0, 0, At, B0); PG8_MMA(0, 1, At, B1); PG8_BAR; PG8_SCHED;
            PG8_LDA(At, 0, 1); PG8_STAGE(PG8_SB(0, 0), b2, voffB); PG8_STAGE(PG8_SB(0, 1), b2 + hstep, voffB); PG8_STAGE(PG8_SA(0, 0), a2, voffA);
            PG8_WAIT_V(8); PG8_WAIT_L(0); PG8_BAR; PG8_MMA(1, 0, At, B0); PG8_MMA(1, 1, At, B1); PG8_BAR; PG8_SCHED;
            PG8_LDB(B0, 1, 0); PG8_LDB(B1, 1, 1); PG8_SCHED; PG8_LDA(At, 1, 0); PG8_STAGE(PG8_SA(0, 1), a2 + hstep, voffA);
            PG8_WAIT_V(8); PG8_WAIT_L(0); PG8_BAR; PG8_MMA(0, 0, At, B0); PG8_MMA(0, 1, At, B1); PG8_BAR; PG8_SCHED;
            PG8_LDA(At, 1, 1); PG8_STAGE(PG8_SB(1, 0), b3, voffB); PG8_STAGE(PG8_SB(1, 1), b3 + hstep, voffB); PG8_STAGE(PG8_SA(1, 0), a3, voffA);
            PG8_WAIT_V(8); PG8_WAIT_L(0); PG8_BAR; PG8_MMA(1, 0, At, B0); PG8_MMA(1, 1, At, B1); PG8_BAR; PG8_SCHED;
            } else {
            PG8_LDB(B0, 0, 0); PG8_SCHED; PG8_LDA(At, 0, 0); PG8_STAGE(PG8_SA(1, 1), a1 + hstep, voffA);
            PG8_WAIT_L(8); PG8_BAR; PG8_WAIT_L(0); PG8_MMA(0, 0, At, B0); PG8_BAR; PG8_SCHED;
            PG8_LDB(B1, 0, 1); PG8_STAGE(PG8_SB(0, 0), b2, voffB);
            PG8_BAR; PG8_WAIT_L(0); PG8_MMA(0, 1, At, B1); PG8_BAR;
            PG8_LDA(At, 0, 1); PG8_STAGE(PG8_SA(0, 0), a2, voffA);
            PG8_BAR; PG8_WAIT_L(0); PG8_MMA(1, 0, At, B0); PG8_BAR; PG8_SCHED;
            PG8_STAGE(PG8_SB(0, 1), b2 + hstep, voffB);
            PG8_WAIT_V(6); PG8_BAR; PG8_MMA(1, 1, At, B1); PG8_BAR;
            PG8_LDB(B0, 1, 0); PG8_SCHED; PG8_LDA(At, 1, 0); PG8_STAGE(PG8_SA(0, 1), a2 + hstep, voffA);
            PG8_WAIT_L(8); PG8_BAR; PG8_WAIT_L(0); PG8_MMA(0, 0, At, B0); PG8_BAR; PG8_SCHED;
            PG8_LDB(B1, 1, 1); PG8_STAGE(PG8_SB(1, 0), b3, voffB);
            PG8_BAR; PG8_WAIT_L(0); PG8_MMA(0, 1, At, B1); PG8_BAR;
            PG8_LDA(At, 1, 1); PG8_STAGE(PG8_SA(1, 0), a3, voffA);
            PG8_BAR; PG8_WAIT_L(0); PG8_MMA(1, 0, At, B0); PG8_BAR; PG8_SCHED;
            PG8_STAGE(PG8_SB(1, 1), b3 + hstep, voffB);
            PG8_WAIT_V(6); PG8_BAR; PG8_MMA(1, 1, At, B1); PG8_BAR;
            }
        }
        if constexpr (ALIGN_EPI) { if (wr == 0) PG8_BAR; }
        if constexpr (!Epi::AFTER_DRAIN) { E(acc, cur, wr, wc, fr, fq); S.done(cur); }
        if (!has_next) break;
#pragma unroll
        for (int a = 0; a < 2; ++a)
#pragma unroll
            for (int b = 0; b < 2; ++b)
#pragma unroll
                for (int m = 0; m < 4; ++m)
#pragma unroll
                    for (int n = 0; n < 2; ++n) acc[a][b][m][n] = (f32x4){0.f, 0.f, 0.f, 0.f};
        cur = nxt; cA = nA; cB = nB; ++ui;
        if constexpr (ALIGN_EPI) { if (wr == 1) PG8_BAR; }
    }
    PG8_WAIT_V(0);
    if constexpr (!ALIGN_EPI) { if (wr == 0) PG8_BAR; }
    PG8_BAR;
    if constexpr (Epi::AFTER_DRAIN) { E.fused(acc, cur, wr, wc, fr, fq, lds, wid, lane); S.done(cur); }
#undef PG8_SA
#undef PG8_SB
#undef PG8_STAGE
#undef PG8_LDA
#undef PG8_LDB
#undef PG8_MMA
#undef PG8_WAIT_V
#undef PG8_WAIT_L
#undef PG8_BAR
#undef PG8_SCHED
}
}

#define LAS __attribute__((address_space(3)))
typedef unsigned short bf16;
typedef short bf16x8 __attribute__((ext_vector_type(8)));
typedef short s16x4 __attribute__((ext_vector_type(4)));
typedef float f32x4 __attribute__((ext_vector_type(4)));
typedef float f32x2 __attribute__((ext_vector_type(2)));
typedef float f32x16 __attribute__((ext_vector_type(16)));
typedef unsigned v4u __attribute__((ext_vector_type(4)));
typedef unsigned v2u __attribute__((ext_vector_type(2)));

constexpr int NWAVES = 8, NTHR = 512;
constexpr int M_TOK = 16384, SEQ = 8192, DM = 1024;
constexpr float LN_EPS = 1e-5f, RMS_EPS = 1e-5f;
constexpr float DN_ALPHA = 1.4142135623730951f;
constexpr float QSCALE = 0.08838834764831845f;
constexpr int LDS_BYTES = 147456;

constexpr size_t MiB = 1u << 20;
constexpr size_t WS_W4T = 1 * MiB, WS_LSE = 3 * MiB, WS_W3T = 4 * MiB, WS_COS = 15 * MiB, WS_SIN = 17 * MiB, WS_X1B = 19 * MiB;
constexpr size_t WS_W1T = 19 * MiB, WS_W2T = 25 * MiB, WS_ALR = 27 * MiB, WS_BEND = 28 * MiB, WS_SST = 29 * MiB;
constexpr size_t WS_OATT = 4 * MiB, WS_QKVG = 68 * MiB, WS_Q = 68 * MiB, WS_V1 = 68 * MiB, WS_XB = 164 * MiB, WS_SLOC = 164 * MiB, WS_OG = 164 * MiB;
constexpr size_t WS_K = 164 * MiB, WS_V = 188 * MiB, WS_G = 212 * MiB, WS_END = 244 * MiB;

struct Params {
    const float *x, *gla_w_in, *gla_w_a2, *gla_b_a2, *gla_norm_g, *gla_w_out, *w_kv, *swa_w_in, *swa_w_out, *ln_g, *ln_b;
    float* out; unsigned char* ws;
    float inv_freq[64];
    int ph_lo, ph_hi;
};

__device__ __forceinline__ unsigned f2bf(float f) { unsigned u = __builtin_bit_cast(unsigned, f); return (u + 0x7fffu + ((u >> 16) & 1u)) >> 16; }
__device__ __forceinline__ unsigned pk2(float lo, float hi) { return f2bf(lo) | (f2bf(hi) << 16); }
__device__ __forceinline__ float bflo(unsigned w) { return __builtin_bit_cast(float, w << 16); }
__device__ __forceinline__ float bfhi(unsigned w) { return __builtin_bit_cast(float, w & 0xffff0000u); }
__device__ __forceinline__ float wave_sum(float v) {
#pragma unroll
    for (int o = 1; o < 64; o <<= 1) v += __shfl_xor(v, o);
    return v;
}
#define LDS_WAIT() asm volatile("s_waitcnt lgkmcnt(0)" ::: "memory")

template <bool ROPEPERM>
__device__ __forceinline__ void p0_transpose_item(const float* W, int K, int ldw, int ncols, bf16* WT, int row_off, LAS float* scr, int item, int lane) {
    const int nblk = ncols / 32, kb = item / nblk, nb = item % nblk, k0 = 64 * kb, n0 = 32 * nb;
#pragma unroll 8
    for (int i = 0; i < 32; ++i) { const int kk = 2 * i + (lane >> 5); scr[kk * 33 + (lane & 31)] = W[(size_t)(k0 + kk) * ldw + n0 + (lane & 31)]; }
    LDS_WAIT(); asm volatile("" ::: "memory");
    const int c = lane & 7;
#pragma unroll
    for (int j = 0; j < 4; ++j) { const int n = (lane >> 3) + 8 * j; const LAS float* s = scr + (8 * c) * 33 + n;
        v4u o; o.x = pk2(s[0 * 33], s[1 * 33]); o.y = pk2(s[2 * 33], s[3 * 33]); o.z = pk2(s[4 * 33], s[5 * 33]); o.w = pk2(s[6 * 33], s[7 * 33]);
        int nd = n0 + n;
        if (ROPEPERM) { const int dim = nd & 127; const int cp = (dim < 64) ? ((dim >> 2) * 8 + (dim & 3)) : (((dim - 64) >> 2) * 8 + 4 + (dim & 3)); nd = (nd & ~127) + cp; }
        *(v4u*)(WT + (size_t)(row_off + nd) * K + k0 + 8 * c) = o; }
    LDS_WAIT(); asm volatile("" ::: "memory");
}

__device__ __forceinline__ void p0_prologue(const Params& p, LAS unsigned char* lds, int tid, int lane, int wave, int G) {
    unsigned char* ws = p.ws;
    const int gw = blockIdx.x * NWAVES + wave, NGW = G * NWAVES;
    {
        LAS float* scr = (LAS float*)(lds + wave * 16384);
        constexpr int I1 = 16 * 96, I2 = 16 * 32, I3K = 16 * 24, I3V = 16 * 24, I3Q = 16 * 96, I3G = 16 * 32, I4 = 16 * 32;
        constexpr int NIT = I1 + I2 + I3K + I3V + I3Q + I3G + I4;
        bf16* W1T = (bf16*)(ws + WS_W1T); bf16* W2T = (bf16*)(ws + WS_W2T); bf16* W3T = (bf16*)(ws + WS_W3T); bf16* W4T = (bf16*)(ws + WS_W4T);
        for (int it = gw; it < NIT; it += NGW) {
            int r = it;
            if (r < I1) { p0_transpose_item<false>(p.gla_w_in, 1024, 3088, 3072, W1T, 0, scr, r, lane); continue; } r -= I1;
            if (r < I2) { p0_transpose_item<false>(p.gla_w_out, 1024, 1024, 1024, W2T, 0, scr, r, lane); continue; } r -= I2;
            if (r < I3K) { p0_transpose_item<true>(p.w_kv, 1024, 1536, 768, W3T, 0, scr, r, lane); continue; } r -= I3K;
            if (r < I3V) { p0_transpose_item<false>(p.w_kv + 768, 1024, 1536, 768, W3T, 768, scr, r, lane); continue; } r -= I3V;
            if (r < I3Q) { p0_transpose_item<true>(p.swa_w_in, 1024, 4096, 3072, W3T, 1536, scr, r, lane); continue; } r -= I3Q;
            if (r < I3G) { p0_transpose_item<false>(p.swa_w_in + 3072, 1024, 4096, 1024, W3T, 1536 + 3072, scr, r, lane); continue; } r -= I3G;
            p0_transpose_item<false>(p.swa_w_out, 1024, 1024, 1024, W4T, 0, scr, r, lane);
        }
    }
    __syncthreads();
    {
        float* cosT = (float*)(ws + WS_COS); float* sinT = (float*)(ws + WS_SIN);
        for (int e = blockIdx.x * NTHR + tid; e < SEQ * 64; e += G * NTHR) {
            const int pos = e >> 6, i = e & 63;
            const float angf = (float)pos * p.inv_freq[i];
            double rev = (double)angf * 0.15915494309189535; rev -= floor(rev);
            const float rf = (float)rev;
            cosT[e] = __builtin_amdgcn_cosf(rf); sinT[e] = __builtin_amdgcn_sinf(rf);
        }
    }
    {
        LAS float* WaT = (LAS float*)lds;
        for (int i = tid; i < 1024 * 4; i += NTHR) { const int k = i >> 2, r4 = (i & 3) * 4;
            const f32x4 w = *(const f32x4*)(p.gla_w_in + (size_t)k * 3088 + 3072 + r4);
            WaT[(r4 + 0) * 1024 + k] = w[0]; WaT[(r4 + 1) * 1024 + k] = w[1]; WaT[(r4 + 2) * 1024 + k] = w[2]; WaT[(r4 + 3) * 1024 + k] = w[3]; }
        __syncthreads();
        bf16* XB = (bf16*)(ws + WS_XB); float* ALR = (float*)(ws + WS_ALR);
        for (int row = gw; row < M_TOK; row += NGW) {
            const f32x4* xr = (const f32x4*)(p.x + (size_t)row * DM) + lane;
            f32x4 v[4];
#pragma unroll
            for (int j = 0; j < 4; ++j) v[j] = xr[64 * j];
            unsigned long long* o8 = (unsigned long long*)(XB + (size_t)row * DM) + lane;
#pragma unroll
            for (int j = 0; j < 4; ++j) o8[64 * j] = (unsigned long long)pk2(v[j][0], v[j][1]) | ((unsigned long long)pk2(v[j][2], v[j][3]) << 32);
            float outv = 0.f;
#pragma unroll 2
            for (int r = 0; r < 16; ++r) {
                float a = 0.f;
#pragma unroll
                for (int j = 0; j < 4; ++j) { const f32x4 w = *(const LAS f32x4*)(WaT + r * 1024 + 256 * j + 4 * lane);
                    a += v[j][0] * w[0] + v[j][1] * w[1] + v[j][2] * w[2] + v[j][3] * w[3]; }
                a = wave_sum(a);
                outv = (lane == r) ? a : outv;
            }
            if (lane < 16) ALR[(size_t)row * 16 + lane] = outv;
        }
        __syncthreads();
    }
}

template <bool WB>
__device__ __forceinline__ void ln_rows(const float* V, float* outF, bf16* outB, const float* g, const float* b, int lane, int wave, int G) {
    const int gw = blockIdx.x * NWAVES + wave, NGW = G * NWAVES;
    f32x4 gv[4], bv[4];
#pragma unroll
    for (int j = 0; j < 4; ++j) { gv[j] = *((const f32x4*)g + lane + 64 * j); bv[j] = *((const f32x4*)b + lane + 64 * j); }
    for (int row = gw; row < M_TOK; row += NGW) {
        const f32x4* xr = (const f32x4*)(V + (size_t)row * DM) + lane;
        f32x4 v[4]; float s = 0.f;
#pragma unroll
        for (int j = 0; j < 4; ++j) { v[j] = xr[64 * j]; s += (v[j][0] + v[j][1]) + (v[j][2] + v[j][3]); }
        const float mean = wave_sum(s) * (1.f / DM); float s2 = 0.f;
#pragma unroll
        for (int j = 0; j < 4; ++j) { v[j] = v[j] - mean; s2 += (v[j][0] * v[j][0] + v[j][1] * v[j][1]) + (v[j][2] * v[j][2] + v[j][3] * v[j][3]); }
        const float rstd = 1.f / sqrtf(wave_sum(s2) * (1.f / DM) + LN_EPS);
        f32x4* of = (f32x4*)(outF + (size_t)row * DM) + lane;
        unsigned long long* o8 = (unsigned long long*)(outB + (size_t)row * DM) + lane;
#pragma unroll
        for (int j = 0; j < 4; ++j) { const f32x4 o = v[j] * rstd * gv[j] + bv[j]; of[64 * j] = o;
            if (WB) o8[64 * j] = (unsigned long long)pk2(o[0], o[1]) | ((unsigned long long)pk2(o[2], o[3]) << 32); }
    }
}

constexpr int GL_ROW = 272;
constexpr int GL_QS = 0, GL_KS = 34816, GL_VT = 69632, GL_TOT = 139264, GL_SSQ = GL_TOT + 4096, GL_ALR = GL_VT;
constexpr int GL_KT = 0;

__device__ __forceinline__ float log_sigmoid_f(float x) { return fminf(x, 0.f) - __logf(1.f + __expf(-fabsf(x))); }

__device__ __forceinline__ void gla_decay(const Params& p, LAS unsigned char* lds, int tok0, int hh, int tid, int lane, int wave, float (&cl)[16][2], float (&bend)[2]) {
    const float* ALR = (const float*)(p.ws + WS_ALR);
    LAS f32x4* alrs = (LAS f32x4*)(lds + GL_ALR);
    alrs[tid] = *((const f32x4*)(ALR + (size_t)tok0 * 16) + tid);
    float wa[16][2];
#pragma unroll
    for (int r = 0; r < 16; ++r) { const f32x2 w = *(const f32x2*)(p.gla_w_a2 + r * 512 + hh * 128 + 2 * lane); wa[r][0] = w[0]; wa[r][1] = w[1]; }
    const f32x2 ba = *(const f32x2*)(p.gla_b_a2 + hh * 128 + 2 * lane);
    __syncthreads();
    float run0 = 0.f, run1 = 0.f;
#pragma unroll
    for (int tt = 0; tt < 16; ++tt) {
        const int t = 16 * wave + tt;
        float x0 = ba[0], x1 = ba[1];
#pragma unroll
        for (int q4 = 0; q4 < 4; ++q4) { const f32x4 a = alrs[t * 4 + q4];
#pragma unroll
            for (int e = 0; e < 4; ++e) { x0 += a[e] * wa[q4 * 4 + e][0]; x1 += a[e] * wa[q4 * 4 + e][1]; } }
        run0 += log_sigmoid_f(x0) * (1.f / 16.f); run1 += log_sigmoid_f(x1) * (1.f / 16.f);
        cl[tt][0] = run0; cl[tt][1] = run1;
    }
    LAS f32x2* tots = (LAS f32x2*)(lds + GL_TOT);
    tots[wave * 64 + lane] = (f32x2){run0, run1};
    __syncthreads();
    float off0 = 0.f, off1 = 0.f, e0 = 0.f, e1 = 0.f;
#pragma unroll
    for (int g = 0; g < 8; ++g) { const f32x2 tv = tots[g * 64 + lane]; if (g < wave) { off0 += tv[0]; off1 += tv[1]; } e0 += tv[0]; e1 += tv[1]; }
#pragma unroll
    for (int tt = 0; tt < 16; ++tt) { cl[tt][0] += off0; cl[tt][1] += off1; }
    bend[0] = e0; bend[1] = e1;
}

__device__ __forceinline__ void gla_load_vt(const bf16* QKVG, LAS unsigned char* lds, int tok0, int hh, int tid) {
    const int dp = tid & 127, tg = tid >> 7;
    const unsigned* src = (const unsigned*)(QKVG + (size_t)(tok0 + 32 * tg) * 3072 + 1024 + hh * 256 + 2 * dp);
#pragma unroll
    for (int g8 = 0; g8 < 4; ++g8) {
        unsigned ld[8];
#pragma unroll
        for (int i = 0; i < 8; ++i) ld[i] = src[(size_t)(g8 * 8 + i) * 1536];
        v4u c0, c1;
#pragma unroll
        for (int i = 0; i < 4; ++i) { c0[i] = (ld[2 * i] & 0xffffu) | (ld[2 * i + 1] << 16); c1[i] = (ld[2 * i] >> 16) | (ld[2 * i + 1] & 0xffff0000u); }
        *(LAS v4u*)(lds + GL_VT + (2 * dp) * GL_ROW + (32 * tg + 8 * g8) * 2) = c0;
        *(LAS v4u*)(lds + GL_VT + (2 * dp + 1) * GL_ROW + (32 * tg + 8 * g8) * 2) = c1;
    }
}

__device__ __forceinline__ void gla_pass_a(const Params& p, LAS unsigned char* lds, int tid, int lane, int wave, int G) {
    const bf16* QKVG = (const bf16*)(p.ws + WS_QKVG); float* SLOC = (float*)(p.ws + WS_SLOC); float* BEND = (float*)(p.ws + WS_BEND);
    const int l32 = lane & 31, hf = lane >> 5;
    for (int task = blockIdx.x; task < 512; task += G) {
        const int bh = task >> 6, sc = task & 63, bb = bh >> 2, hh = bh & 3;
        const int tok0 = bb * SEQ + sc * 128;
        float cl[16][2], bend[2];
        gla_decay(p, lds, tok0, hh, tid, lane, wave, cl, bend);
        if (wave == 0) *(f32x2*)(BEND + (size_t)task * 128 + 2 * lane) = (f32x2){bend[0], bend[1]};
        {
            const unsigned* ksrc = (const unsigned*)(QKVG + (size_t)(tok0 + 16 * wave) * 3072 + 512 + hh * 128 + 2 * lane);
            unsigned kv[16];
#pragma unroll
            for (int tt = 0; tt < 16; ++tt) kv[tt] = ksrc[(size_t)tt * 1536];
            float k0[16], k1[16];
#pragma unroll
            for (int tt = 0; tt < 16; ++tt) { k0[tt] = bflo(kv[tt]) * __expf(bend[0] - cl[tt][0]); k1[tt] = bfhi(kv[tt]) * __expf(bend[1] - cl[tt][1]); }
#pragma unroll
            for (int h8 = 0; h8 < 2; ++h8) { v4u c0, c1;
#pragma unroll
                for (int i = 0; i < 4; ++i) { c0[i] = pk2(k0[h8 * 8 + 2 * i], k0[h8 * 8 + 2 * i + 1]); c1[i] = pk2(k1[h8 * 8 + 2 * i], k1[h8 * 8 + 2 * i + 1]); }
                *(LAS v4u*)(lds + GL_KT + (2 * lane) * GL_ROW + (16 * wave + 8 * h8) * 2) = c0;
                *(LAS v4u*)(lds + GL_KT + (2 * lane + 1) * GL_ROW + (16 * wave + 8 * h8) * 2) = c1; }
        }
        gla_load_vt(QKVG, lds, tok0, hh, tid);
        __syncthreads();
        f32x16 acc[4];
#pragma unroll
        for (int j = 0; j < 4; ++j)
#pragma unroll
            for (int r = 0; r < 16; ++r) acc[j][r] = 0.f;
#pragma unroll
        for (int s = 0; s < 8; ++s) {
            const bf16x8 a = *(const LAS bf16x8*)(lds + GL_VT + (32 * wave + l32) * GL_ROW + (16 * s + 8 * hf) * 2);
#pragma unroll
            for (int j = 0; j < 4; ++j) { const bf16x8 b = *(const LAS bf16x8*)(lds + GL_KT + (32 * j + l32) * GL_ROW + (16 * s + 8 * hf) * 2);
                acc[j] = __builtin_amdgcn_mfma_f32_32x32x16_bf16(a, b, acc[j], 0, 0, 0); }
        }
        float* dst = SLOC + (size_t)task * 32768;
#pragma unroll
        for (int j = 0; j < 4; ++j)
#pragma unroll
            for (int r = 0; r < 16; ++r) { const int dv = 32 * wave + (r & 3) + 8 * (r >> 2) + 4 * hf; dst[dv * 128 + 32 * j + l32] = acc[j][r]; }
        __syncthreads();
    }
}

__device__ __forceinline__ void gla_pass_b(const Params& p, int tid, int G) {
    const float* SLOC = (const float*)(p.ws + WS_SLOC); const float* BEND = (const float*)(p.ws + WS_BEND); bf16* SST = (bf16*)(p.ws + WS_SST);
    for (int e = blockIdx.x * NTHR + tid; e < 8 * 32768; e += G * NTHR) {
        const int bh = e >> 15, el = e & 32767, dk = el & 127;
        float s = 0.f;
        for (int sc0 = 0; sc0 < 64; sc0 += 8) {
            float lv[8], dc[8];
#pragma unroll
            for (int i = 0; i < 8; ++i) { lv[i] = SLOC[(size_t)(bh * 64 + sc0 + i) * 32768 + el]; dc[i] = BEND[(bh * 64 + sc0 + i) * 128 + dk]; }
#pragma unroll
            for (int i = 0; i < 8; ++i) { SST[(size_t)(bh * 64 + sc0 + i) * 32768 + el] = (bf16)f2bf(s); s = s * __expf(dc[i]) + lv[i]; }
        }
    }
}

__device__ __forceinline__ void gla_pass_c(const Params& p, LAS unsigned char* lds, int tid, int lane, int wave, int G) {
    const bf16* QKVG = (const bf16*)(p.ws + WS_QKVG); const bf16* SST = (const bf16*)(p.ws + WS_SST); bf16* OG = (bf16*)(p.ws + WS_OG);
    const int l32 = lane & 31, hf = lane >> 5;
    const int ts = wave & 3, dh = wave >> 2;
    for (int task = blockIdx.x; task < 512; task += G) {
        const int bh = task >> 6, sc = task & 63, bb = bh >> 2, hh = bh & 3;
        const int tok0 = bb * SEQ + sc * 128;
        {
            float cl[16][2], bend[2];
            gla_decay(p, lds, tok0, hh, tid, lane, wave, cl, bend);
            const unsigned* qsrc = (const unsigned*)(QKVG + (size_t)(tok0 + 16 * wave) * 3072 + hh * 128 + 2 * lane);
            const unsigned* ksrc = qsrc + 256;
            unsigned qv[16], kv[16];
#pragma unroll
            for (int tt = 0; tt < 16; ++tt) { qv[tt] = qsrc[(size_t)tt * 1536]; kv[tt] = ksrc[(size_t)tt * 1536]; }
#pragma unroll
            for (int tt = 0; tt < 16; ++tt) {
                const float e0 = __expf(cl[tt][0]), e1 = __expf(cl[tt][1]), n0 = __expf(-cl[tt][0]), n1 = __expf(-cl[tt][1]);
                *(LAS unsigned*)(lds + GL_QS + (16 * wave + tt) * GL_ROW + 4 * lane) = pk2(bflo(qv[tt]) * e0, bfhi(qv[tt]) * e1);
                *(LAS unsigned*)(lds + GL_KS + (16 * wave + tt) * GL_ROW + 4 * lane) = pk2(bflo(kv[tt]) * n0, bfhi(kv[tt]) * n1);
            }
        }
        gla_load_vt(QKVG, lds, tok0, hh, tid);
        __syncthreads();
        bf16x8 qf[8];
#pragma unroll
        for (int s = 0; s < 8; ++s) qf[s] = *(const LAS bf16x8*)(lds + GL_QS + (32 * ts + l32) * GL_ROW + (16 * s + 8 * hf) * 2);
        f32x16 O[4];
#pragma unroll
        for (int j = 0; j < 4; ++j)
#pragma unroll
            for (int r = 0; r < 16; ++r) O[j][r] = 0.f;
        {
            const bf16* st = SST + (size_t)task * 32768;
#pragma unroll
            for (int dt = 0; dt < 4; ++dt) {
                const bf16* srow = st + (size_t)(128 * dh + 32 * dt + l32) * 128 + 8 * hf;
#pragma unroll
                for (int s = 0; s < 8; ++s) { const bf16x8 a = *(const bf16x8*)(srow + 16 * s); O[dt] = __builtin_amdgcn_mfma_f32_32x32x16_bf16(a, qf[s], O[dt], 0, 0, 0); }
            }
        }
        for (int jb = 0; jb <= ts; ++jb) {
            f32x16 att;
#pragma unroll
            for (int r = 0; r < 16; ++r) att[r] = 0.f;
#pragma unroll
            for (int s = 0; s < 8; ++s) { const bf16x8 a = *(const LAS bf16x8*)(lds + GL_KS + (32 * jb + l32) * GL_ROW + (16 * s + 8 * hf) * 2);
                att = __builtin_amdgcn_mfma_f32_32x32x16_bf16(a, qf[s], att, 0, 0, 0); }
            if (jb == ts) {
#pragma unroll
                for (int r = 0; r < 16; ++r) { const int row = (r & 3) + 8 * (r >> 2) + 4 * hf; att[r] = (row <= l32) ? att[r] : 0.f; }
            }
            bf16x8 pf[2];
#pragma unroll
            for (int s2 = 0; s2 < 2; ++s2) { v4u w;
#pragma unroll
                for (int i = 0; i < 4; ++i) w[i] = pk2(att[8 * s2 + 2 * i], att[8 * s2 + 2 * i + 1]);
                pf[s2] = __builtin_bit_cast(bf16x8, w); }
#pragma unroll
            for (int dt = 0; dt < 4; ++dt) {
                const LAS unsigned char* vrow = lds + GL_VT + (128 * dh + 32 * dt + l32) * GL_ROW + (32 * jb + 4 * hf) * 2;
#pragma unroll
                for (int s2 = 0; s2 < 2; ++s2) {
                    const v2u lo = *(const LAS v2u*)(vrow + (16 * s2) * 2), hi = *(const LAS v2u*)(vrow + (16 * s2 + 8) * 2);
                    const v4u av = (v4u){lo[0], lo[1], hi[0], hi[1]};
                    O[dt] = __builtin_amdgcn_mfma_f32_32x32x16_bf16(__builtin_bit_cast(bf16x8, av), pf[s2], O[dt], 0, 0, 0);
                }
            }
        }
        float ssq = 0.f;
#pragma unroll
        for (int dt = 0; dt < 4; ++dt)
#pragma unroll
            for (int r = 0; r < 16; ++r) ssq += O[dt][r] * O[dt][r];
        ssq += __shfl_xor(ssq, 32);
        LAS float* ssqs = (LAS float*)(lds + GL_SSQ);
        if (hf == 0) ssqs[dh * 128 + 32 * ts + l32] = ssq;
        __syncthreads();
        const float tot = ssqs[32 * ts + l32] + ssqs[128 + 32 * ts + l32];
        const float rstd = 1.f / sqrtf(tot * (1.f / 256.f) + RMS_EPS);
        const size_t trow = (size_t)(tok0 + 32 * ts + l32);
#pragma unroll
        for (int dt = 0; dt < 4; ++dt)
#pragma unroll
            for (int rq = 0; rq < 4; ++rq) {
                const int dv = 128 * dh + 32 * dt + 8 * rq + 4 * hf;
                const v2u gw2 = *(const v2u*)(QKVG + trow * 3072 + 2048 + hh * 256 + dv);
                const f32x4 ng = *(const f32x4*)(p.gla_norm_g + hh * 256 + dv);
                float gv[4] = {bflo(gw2[0]), bfhi(gw2[0]), bflo(gw2[1]), bfhi(gw2[1])};
                float ov[4];
#pragma unroll
                for (int e = 0; e < 4; ++e) { const float gg = gv[e]; const float sl = gg / (1.f + __expf(-gg)); ov[e] = O[dt][4 * rq + e] * rstd * ng[e] * sl; }
                v2u ow; ow[0] = pk2(ov[0], ov[1]); ow[1] = pk2(ov[2], ov[3]);
                *(v2u*)(OG + trow * 1024 + hh * 256 + dv) = ow;
            }
        __syncthreads();
    }
}

constexpr int AT_KROW = 272, AT_VROW = 528;
constexpr int AT_KS = 0, AT_VT = 256 * AT_KROW;
template <bool MERGE>
__device__ __forceinline__ void attn_phase(const Params& p, LAS unsigned char* lds, int tid, int lane, int wave, int G) {
    const bf16* Kb = (const bf16*)(p.ws + WS_K); const bf16* Vb = (const bf16*)(p.ws + WS_V); const bf16* Qb = (const bf16*)(p.ws + WS_Q);
    bf16* Gb = (bf16*)(p.ws + WS_G); bf16* OATT = (bf16*)(p.ws + WS_OATT); float* LSE = (float*)(p.ws + WS_LSE);
    const int l32 = lane & 31, hf = lane >> 5;
    const int ntask = MERGE ? 256 : 512;
    for (int task = blockIdx.x; task < ntask; task += G) {
        int g, bb, kvh, blk;
        if (MERGE) { g = 0; bb = task >> 7; kvh = (task >> 6) & 1; blk = task & 63; }
        else { g = 1 + (task >> 8); bb = (task >> 7) & 1; kvh = (task >> 6) & 1; blk = task & 63; }
        const int dil = (g == 0) ? 1 : (g == 1 ? 4 : 16);
        const int nb = 64 / dil;
        const int rr = blk / nb, n = blk % nb;
        const int kvcol = (g * 2 + kvh) * 128;
        for (int id = tid; id < 256 * 16; id += NTHR) {
            const int row = id >> 4, ch = id & 15;
            v4u val = (v4u){0u, 0u, 0u, 0u};
            if (n > 0 || row >= 128) { const int tok = ((n - 1) * 128 + row) * dil + rr; val = *(const v4u*)(Kb + (size_t)(bb * SEQ + tok) * 768 + kvcol + ch * 8); }
            *(LAS v4u*)(lds + AT_KS + row * AT_KROW + ch * 16) = val;
        }
        {
#pragma unroll
            for (int g8 = 0; g8 < 4; ++g8) {
                unsigned ld[8];
#pragma unroll
                for (int i = 0; i < 8; ++i) { const int row = 32 * wave + 8 * g8 + i; unsigned vv = 0u;
                    if (n > 0 || row >= 128) { const int tok = ((n - 1) * 128 + row) * dil + rr; vv = *(const unsigned*)(Vb + (size_t)(bb * SEQ + tok) * 768 + kvcol + 2 * lane); }
                    ld[i] = vv; }
                v4u c0, c1;
#pragma unroll
                for (int i = 0; i < 4; ++i) { c0[i] = (ld[2 * i] & 0xffffu) | (ld[2 * i + 1] << 16); c1[i] = (ld[2 * i] >> 16) | (ld[2 * i + 1] & 0xffff0000u); }
                *(LAS v4u*)(lds + AT_VT + (2 * lane) * AT_VROW + (32 * wave + 8 * g8) * 2) = c0;
                *(LAS v4u*)(lds + AT_VT + (2 * lane + 1) * AT_VROW + (32 * wave + 8 * g8) * 2) = c1;
            }
        }
        __syncthreads();
        for (int it = 0; it < 2; ++it) {
            const int job = it * 8 + wave, hq = job >> 2, qs = job & 3;
            const int head = kvh * 4 + hq;
            const int qtok = bb * SEQ + (n * 128 + 32 * qs + l32) * dil + rr;
            bf16x8 qf[8];
            {
                const bf16* qrow = Qb + (size_t)qtok * 3072 + (g * 8 + head) * 128 + 8 * hf;
#pragma unroll
                for (int s = 0; s < 8; ++s) qf[s] = *(const bf16x8*)(qrow + 16 * s);
            }
            f32x16 sc[5];
#pragma unroll
            for (int kt = 0; kt < 5; ++kt) {
#pragma unroll
                for (int r = 0; r < 16; ++r) sc[kt][r] = 0.f;
                const LAS unsigned char* krow = lds + AT_KS + (32 * (qs + kt) + l32) * AT_KROW + 16 * hf;
#pragma unroll
                for (int s = 0; s < 8; ++s) { const bf16x8 a = *(const LAS bf16x8*)(krow + 32 * s); sc[kt] = __builtin_amdgcn_mfma_f32_32x32x16_bf16(a, qf[s], sc[kt], 0, 0, 0); }
                __builtin_amdgcn_sched_barrier(0);
            }
            const float NEG = -1e30f;
            float mx = NEG;
#pragma unroll
            for (int kt = 0; kt < 5; ++kt) {
                const bool tile_ok = (n > 0) || (qs + kt >= 4);
#pragma unroll
                for (int r = 0; r < 16; ++r) { const int row = (r & 3) + 8 * (r >> 2) + 4 * hf;
                    bool ok = tile_ok;
                    if (kt == 0) ok = ok && (row >= l32);
                    if (kt == 4) ok = ok && (row <= l32);
                    const float v = ok ? sc[kt][r] : NEG; sc[kt][r] = v; mx = fmaxf(mx, v); }
            }
            mx = fmaxf(mx, __shfl_xor(mx, 32));
            float den = 0.f;
#pragma unroll
            for (int kt = 0; kt < 5; ++kt)
#pragma unroll
                for (int r = 0; r < 16; ++r) { const float e = __expf(sc[kt][r] - mx); sc[kt][r] = e; den += e; }
            den += __shfl_xor(den, 32);
            f32x16 O[4];
#pragma unroll
            for (int j = 0; j < 4; ++j)
#pragma unroll
                for (int r = 0; r < 16; ++r) O[j][r] = 0.f;
#pragma unroll
            for (int kt = 0; kt < 5; ++kt) {
                bf16x8 pf[2];
#pragma unroll
                for (int s2 = 0; s2 < 2; ++s2) { v4u w;
#pragma unroll
                    for (int i = 0; i < 4; ++i) w[i] = pk2(sc[kt][8 * s2 + 2 * i], sc[kt][8 * s2 + 2 * i + 1]);
                    pf[s2] = __builtin_bit_cast(bf16x8, w); }
#pragma unroll
                for (int dt = 0; dt < 4; ++dt) {
                    const LAS unsigned char* vrow = lds + AT_VT + (32 * dt + l32) * AT_VROW + (32 * (qs + kt) + 4 * hf) * 2;
#pragma unroll
                    for (int s2 = 0; s2 < 2; ++s2) {
                        const v2u lo = *(const LAS v2u*)(vrow + (16 * s2) * 2), hi = *(const LAS v2u*)(vrow + (16 * s2 + 8) * 2);
                        const v4u av = (v4u){lo[0], lo[1], hi[0], hi[1]};
                        O[dt] = __builtin_amdgcn_mfma_f32_32x32x16_bf16(__builtin_bit_cast(bf16x8, av), pf[s2], O[dt], 0, 0, 0);
                    }
                    __builtin_amdgcn_sched_barrier(0);
                }
            }
            const float inv = 1.f / den;
            const float lse = mx + __logf(den);
            if (!MERGE) {
                bf16* orow = OATT + (size_t)(g - 1) * M_TOK * 1024 + (size_t)qtok * 1024 + head * 128;
#pragma unroll
                for (int dt = 0; dt < 4; ++dt)
#pragma unroll
                    for (int rq = 0; rq < 4; ++rq) { const int dv = 32 * dt + 8 * rq + 4 * hf;
                        v2u ow; ow[0] = pk2(O[dt][4 * rq] * inv, O[dt][4 * rq + 1] * inv); ow[1] = pk2(O[dt][4 * rq + 2] * inv, O[dt][4 * rq + 3] * inv);
                        *(v2u*)(orow + dv) = ow; }
                if (hf == 0) LSE[(size_t)(g - 1) * M_TOK * 8 + (size_t)qtok * 8 + head] = lse;
            } else {
                const float l1 = LSE[(size_t)qtok * 8 + head], l2 = LSE[(size_t)M_TOK * 8 + (size_t)qtok * 8 + head];
                const float mm = fmaxf(lse, fmaxf(l1, l2));
                const float e0 = __expf(lse - mm), e1 = __expf(l1 - mm), e2 = __expf(l2 - mm);
                const float rs = 1.f / (e0 + e1 + e2);
                const float w0 = e0 * rs * inv, w1 = e1 * rs, w2 = e2 * rs;
                const bf16* o1row = OATT + (size_t)qtok * 1024 + head * 128;
                const bf16* o2row = o1row + (size_t)M_TOK * 1024;
                bf16* grow = Gb + (size_t)qtok * 1024 + head * 128;
#pragma unroll
                for (int dt = 0; dt < 4; ++dt)
#pragma unroll
                    for (int rq = 0; rq < 4; ++rq) { const int dv = 32 * dt + 8 * rq + 4 * hf;
                        const v2u a1 = *(const v2u*)(o1row + dv), a2 = *(const v2u*)(o2row + dv), gg = *(const v2u*)(grow + dv);
                        const float o1v[4] = {bflo(a1[0]), bfhi(a1[0]), bflo(a1[1]), bfhi(a1[1])};
                        const float o2v[4] = {bflo(a2[0]), bfhi(a2[0]), bflo(a2[1]), bfhi(a2[1])};
                        const float gv[4] = {bflo(gg[0]), bfhi(gg[0]), bflo(gg[1]), bfhi(gg[1])};
                        float ov[4];
#pragma unroll
                        for (int e = 0; e < 4; ++e) { const float m = O[dt][4 * rq + e] * w0 + o1v[e] * w1 + o2v[e] * w2; ov[e] = m * (gv[e] / (1.f + __expf(-gv[e]))); }
                        v2u ow; ow[0] = pk2(ov[0], ov[1]); ow[1] = pk2(ov[2], ov[3]);
                        *(v2u*)(grow + dv) = ow; __builtin_amdgcn_sched_barrier(0); }
            }
        }
        __syncthreads();
    }
}

__global__ void __launch_bounds__(NTHR, 2) yoco_fwd(Params p) {
    extern __shared__ __attribute__((aligned(16))) unsigned char lds_raw[];
    LAS unsigned char* lds = (LAS unsigned char*)lds_raw;
    cg::grid_group grid = cg::this_grid();
    const int tid = threadIdx.x, lane = tid & 63, wave = __builtin_amdgcn_readfirstlane(tid >> 6);
    const int G = gridDim.x;
    unsigned char* ws = p.ws;
    const int lo = p.ph_lo, hi = p.ph_hi;
#ifdef ONLY_PH
#define IN(k) ((k) == ONLY_PH && lo <= (k) && (k) < hi)
#else
#define IN(k) (lo <= (k) && (k) < hi)
#endif
#define SEAM(k) do { if (IN(k) && IN((k) + 1)) grid.sync(); } while (0)

    if (IN(0)) { p0_prologue(p, lds, tid, lane, wave, G); }
    SEAM(0);
    if (IN(1)) {
        pg8::Gemm g{(const pg8::bf16_t*)(ws + WS_XB), (const pg8::bf16_t*)(ws + WS_W1T), M_TOK, 3072, 1024}; pg8::StaticOrder S; S.init(M_TOK, 3072, G, (int)blockIdx.x);
        pg8::EpiGla1 E{(pg8::bf16_t*)(ws + WS_QKVG), QSCALE};
        pg8::gemm_phase<pg8::EpiGla1, pg8::StaticOrder, true, true>(lds, g, S, E);
    }
    SEAM(1);
    if (IN(2)) gla_pass_a(p, lds, tid, lane, wave, G);
    SEAM(2);
    if (IN(3)) gla_pass_b(p, tid, G);
    SEAM(3);
    if (IN(4)) gla_pass_c(p, lds, tid, lane, wave, G);
    SEAM(4);
    if (IN(5)) {
        pg8::Gemm g{(const pg8::bf16_t*)(ws + WS_OG), (const pg8::bf16_t*)(ws + WS_W2T), M_TOK, 1024, 1024}; pg8::StaticOrder S; S.init(M_TOK, 1024, G, (int)blockIdx.x);
        pg8::EpiResid E{p.x, (float*)(ws + WS_V1), DN_ALPHA};
        pg8::gemm_phase<pg8::EpiResid, pg8::StaticOrder, true, true>(lds, g, S, E);
    }
    SEAM(5);
    if (IN(6)) ln_rows<true>((const float*)(ws + WS_V1), p.out, (bf16*)(ws + WS_X1B), p.ln_g, p.ln_b, lane, wave, G);
    SEAM(6);
    if (IN(7)) {
        pg8::Gemm g{(const pg8::bf16_t*)(ws + WS_X1B), (const pg8::bf16_t*)(ws + WS_W3T), M_TOK, 5632, 1024}; pg8::StaticOrder S; S.init(M_TOK, 5632, G, (int)blockIdx.x);
        pg8::EpiRope E{(pg8::bf16_t*)(ws + WS_K), (pg8::bf16_t*)(ws + WS_V), (pg8::bf16_t*)(ws + WS_Q), (pg8::bf16_t*)(ws + WS_G), (const float*)(ws + WS_COS), (const float*)(ws + WS_SIN), QSCALE};
        pg8::gemm_phase<pg8::EpiRope, pg8::StaticOrder, true, true>(lds, g, S, E);
    }
    SEAM(7);
    if (IN(8)) attn_phase<false>(p, lds, tid, lane, wave, G);
    SEAM(8);
    if (IN(9)) attn_phase<true>(p, lds, tid, lane, wave, G);
    SEAM(9);
    if (IN(10)) {
        pg8::Gemm g{(const pg8::bf16_t*)(ws + WS_G), (const pg8::bf16_t*)(ws + WS_W4T), M_TOK, 1024, 1024}; pg8::StaticOrder S; S.init(M_TOK, 1024, G, (int)blockIdx.x);
        pg8::EpiResid E{p.out, (float*)(ws + WS_V1), DN_ALPHA};
        pg8::gemm_phase<pg8::EpiResid, pg8::StaticOrder, true, true>(lds, g, S, E);
    }
    SEAM(10);
    if (IN(11)) ln_rows<false>((const float*)(ws + WS_V1), p.out, (bf16*)nullptr, p.ln_g + DM, p.ln_b + DM, lane, wave, G);
#undef IN
#undef SEAM
}

#ifndef N_LAUNCH_SPLIT
#define N_LAUNCH_SPLIT 0
#endif
extern "C" void kernel_launch(void* const* d_in, const int* in_sizes, int n_in, void* d_out, int out_size, void* d_ws, size_t ws_size, hipStream_t stream) {
    static int grid = 0;
    if (grid == 0) {
        int dev = 0, cus = 0, per_cu = 0;
        hipGetDevice(&dev);
        hipDeviceGetAttribute(&cus, hipDeviceAttributeMultiprocessorCount, dev);
        hipFuncSetAttribute((const void*)yoco_fwd, hipFuncAttributeMaxDynamicSharedMemorySize, LDS_BYTES);
        hipOccupancyMaxActiveBlocksPerMultiprocessor(&per_cu, (const void*)yoco_fwd, NTHR, LDS_BYTES);
        if (per_cu < 1) { fprintf(stderr, "kernel_launch: occupancy query says %d blocks/CU\n", per_cu); per_cu = 1; }
        grid = cus * per_cu;
        (void)hipGetLastError();
    }
    Params p;
    memset(&p, 0, sizeof(p));
    p.x = (const float*)d_in[0]; p.gla_w_in = (const float*)d_in[1]; p.gla_w_a2 = (const float*)d_in[2]; p.gla_b_a2 = (const float*)d_in[3];
    p.gla_norm_g = (const float*)d_in[4]; p.gla_w_out = (const float*)d_in[5]; p.w_kv = (const float*)d_in[6]; p.swa_w_in = (const float*)d_in[7];
    p.swa_w_out = (const float*)d_in[8]; p.ln_g = (const float*)d_in[9]; p.ln_b = (const float*)d_in[10];
    p.out = (float*)d_out; p.ws = (unsigned char*)d_ws;
    for (int i = 0; i < 64; ++i) p.inv_freq[i] = powf(10000.0f, -((float)i * 2.0f) / 128.0f);
#if N_LAUNCH_SPLIT
    for (int ph = 0; ph < 12; ++ph) { p.ph_lo = ph; p.ph_hi = ph + 1; hipLaunchKernelGGL(yoco_fwd, dim3(grid), dim3(NTHR), LDS_BYTES, stream, p); }
#else
    p.ph_lo = 0; p.ph_hi = 12;
    void* args[] = {&p};
    hipError_t e = hipLaunchCooperativeKernel((const void*)yoco_fwd, dim3(grid), dim3(NTHR), args, LDS_BYTES, stream);
    if (e != hipSuccess) fprintf(stderr, "cooperative launch failed: %s (grid %d)\n", hipGetErrorString(e), grid);
#endif
}
```

```cpp
#include <hip/hip_runtime.h>
#include <hip/hip_cooperative_groups.h>
#include <cstdio>
#include <cstdint>
#include <cstring>
#include <cmath>
namespace cg = cooperative_groups;
namespace pg8 {
#define PG8_LAS __attribute__((address_space(3)))
typedef unsigned short bf16_t;
typedef short bf16x8 __attribute__((ext_vector_type(8)));
typedef float f32x4 __attribute__((ext_vector_type(4)));
typedef unsigned u32x4 __attribute__((ext_vector_type(4)));
constexpr int BM = 256, BK = 64, HALF = 128, HTB = HALF * BK * 2  , STAGE_BYTES = 8 * HTB, NXCD = 8, WGM = 8;

__host__ __device__ __forceinline__ int lds_byte(int r, int c) { const int st = (r >> 4) * 2 + (c >> 5), rr = r & 15, cc = c & 31, ob = rr * 64 + cc * 2; return st * 1024 + (ob ^ (((ob >> 9) & 1) << 5)); }
__host__ __device__ __forceinline__ void stage_rc(int b, int& R, int& C) { const int st = b / 1024, sb = b % 1024, swz = sb ^ (((sb >> 9) & 1) << 5); R = (st >> 1) * 16 + swz / 64; C = (st & 1) * 32 + (swz % 64) / 2; }
__host__ __device__ __forceinline__ int perm32(int rho) { const int n = rho >> 4, i = rho & 15; return 8 * (i >> 2) + 4 * n + (i & 3); }

struct Unit { int pm, pn; };
struct Gemm { const bf16_t* A; const bf16_t* Bt; int M, N, K; };

struct StaticOrder {
    int nM, nN, nwg, G, c;
    __host__ __device__ void init(int M, int N, int G_, int c_) { nM = M / BM; nN = N / BM; nwg = nM * nN; G = G_; c = c_; }
    __host__ __device__ bool next(int i, Unit& u) const {
        const long L = (long)i * G + c; if (L >= nwg) return false;
        int wgid = (int)L; { const int q = nwg / NXCD, r = nwg % NXCD, xcd = wgid % NXCD, off = wgid / NXCD; wgid = (xcd < r ? xcd * (q + 1) : r * (q + 1) + (xcd - r) * q) + off; }
        const int nig = WGM * nN, gid = wgid / nig, fm = gid * WGM, gsz = (nM - fm) < WGM ? (nM - fm) : WGM;
        u.pm = fm + ((wgid % nig) % gsz); u.pn = (wgid % nig) / gsz; return true;
    }
    __device__ __forceinline__ void a_ready(const Unit&) const {}
    __device__ __forceinline__ void done(const Unit&) const {}
};
__device__ __forceinline__ unsigned cvt_pk_bf16(float lo, float hi) { unsigned r; asm volatile("v_cvt_pk_bf16_f32 %0, %1, %2" : "=v"(r) : "v"(lo), "v"(hi)); return r; }
typedef unsigned u32x2 __attribute__((ext_vector_type(2)));
struct EpiGla1 {
    static constexpr bool PERM = true, AFTER_DRAIN = false;
    bf16_t* O; float qscale;
    __device__ __forceinline__ void operator()(const f32x4 (&acc)[2][2][4][2], const Unit& u, int wr, int wc, int fr, int fq) const {
        const int row0 = u.pm * BM + wr * 64 + fr, col0 = u.pn * BM + wc * 32 + 8 * fq;
        const float sc = (u.pn < 2) ? qscale : 1.f;
#pragma unroll
        for (int ai = 0; ai < 2; ++ai)
#pragma unroll
            for (int m = 0; m < 4; ++m) { bf16_t* rowp = O + (size_t)(row0 + ai * HALF + m * 16) * 3072 + col0;
#pragma unroll
                for (int bj = 0; bj < 2; ++bj) { const f32x4 v0 = acc[ai][bj][m][0] * sc, v1 = acc[ai][bj][m][1] * sc;
                    u32x4 w; w.x = cvt_pk_bf16(v0[0], v0[1]); w.y = cvt_pk_bf16(v0[2], v0[3]); w.z = cvt_pk_bf16(v1[0], v1[1]); w.w = cvt_pk_bf16(v1[2], v1[3]);
                    *(u32x4*)(rowp + bj * HALF) = w; } }
    }
};
struct EpiResid {
    static constexpr bool PERM = false, AFTER_DRAIN = false;
    const float* resid; float* V; float alpha;
    __device__ __forceinline__ void operator()(const f32x4 (&acc)[2][2][4][2], const Unit& u, int wr, int wc, int fr, int fq) const {
        const int row0 = u.pm * BM + wr * 64 + fr, col0 = u.pn * BM + wc * 32 + 4 * fq;
#pragma unroll
        for (int ai = 0; ai < 2; ++ai)
#pragma unroll
            for (int m = 0; m < 4; ++m) { const size_t off = (size_t)(row0 + ai * HALF + m * 16) * 1024 + col0;
#pragma unroll
                for (int bj = 0; bj < 2; ++bj)
#pragma unroll
                    for (int n = 0; n < 2; ++n) { const f32x4 rs = *(const f32x4*)(resid + off + bj * HALF + n * 16);
                        *(f32x4*)(V + off + bj * HALF + n * 16) = rs * alpha + acc[ai][bj][m][n]; } }
    }
};
struct EpiRope {
    static constexpr bool PERM = true, AFTER_DRAIN = false;
    bf16_t *Kb, *Vb, *Qb, *Gb; const float* cosT; const float* sinT; float qscale;
    __device__ __forceinline__ void operator()(const f32x4 (&acc)[2][2][4][2], const Unit& u, int wr, int wc, int fr, int fq) const {
        const int row0 = u.pm * BM + wr * 64 + fr;
        const int pn = u.pn;
        const bool rope = (pn < 3) || (pn >= 6 && pn < 18);
        bf16_t* base; int ld, ct; float sc = 1.f;
        if (pn < 3) { base = Kb; ld = 768; ct = pn * BM; }
        else if (pn < 6) { base = Vb; ld = 768; ct = (pn - 3) * BM; }
        else if (pn < 18) { base = Qb; ld = 3072; ct = (pn - 6) * BM; sc = qscale; }
        else { base = Gb; ld = 1024; ct = (pn - 18) * BM; }
        if (rope) {
            const int i0 = 4 * (4 * wc + fq);
#pragma unroll
            for (int ai = 0; ai < 2; ++ai)
#pragma unroll
                for (int m = 0; m < 4; ++m) { const int row = row0 + ai * HALF + m * 16; const int pos = row & 8191;
                    const f32x4 c = *(const f32x4*)(cosT + pos * 64 + i0) * sc, s = *(const f32x4*)(sinT + pos * 64 + i0) * sc;
                    bf16_t* rowp = base + (size_t)row * ld + ct + i0;
#pragma unroll
                    for (int bj = 0; bj < 2; ++bj) { const f32x4 x1 = acc[ai][bj][m][0], x2 = acc[ai][bj][m][1];
                        const f32x4 o1 = x1 * c - x2 * s, o2 = x2 * c + x1 * s;
                        u32x2 w1, w2; w1.x = cvt_pk_bf16(o1[0], o1[1]); w1.y = cvt_pk_bf16(o1[2], o1[3]); w2.x = cvt_pk_bf16(o2[0], o2[1]); w2.y = cvt_pk_bf16(o2[2], o2[3]);
                        *(u32x2*)(rowp + bj * HALF) = w1; *(u32x2*)(rowp + bj * HALF + 64) = w2; } }
        } else {
            const int col0 = ct + wc * 32 + 8 * fq;
#pragma unroll
            for (int ai = 0; ai < 2; ++ai)
#pragma unroll
                for (int m = 0; m < 4; ++m) { bf16_t* rowp = base + (size_t)(row0 + ai * HALF + m * 16) * ld + col0;
#pragma unroll
                    for (int bj = 0; bj < 2; ++bj) { const f32x4 v0 = acc[ai][bj][m][0], v1 = acc[ai][bj][m][1];
                        u32x4 w; w.x = cvt_pk_bf16(v0[0], v0[1]); w.y = cvt_pk_bf16(v0[2], v0[3]); w.z = cvt_pk_bf16(v1[0], v1[1]); w.w = cvt_pk_bf16(v1[2], v1[3]);
                        *(u32x4*)(rowp + bj * HALF) = w; } }
        }
    }
};

template <class Epi, class Sched, bool ALIGN_EPI = false, bool SP2 = false>
__device__ __forceinline__ void gemm_phase(PG8_LAS unsigned char* lds, const Gemm g, const Sched& S, const Epi& E) {
    const int tid = threadIdx.x, wid = __builtin_amdgcn_readfirstlane(tid >> 6), lane = tid & 63, wr = wid >> 2, wc = wid & 3, fr = lane & 15, fq = lane >> 4;
    const int K = g.K, nt = K / BK;
    unsigned voffA[2], voffB[2];
#pragma unroll
    for (int i = 0; i < 2; ++i) { int R, C; stage_rc(tid * 16 + i * 8192, R, C); const int Rb = Epi::PERM ? ((R & ~31) + perm32(R & 31)) : R;
        voffA[i] = (unsigned)(R * K + C) * 2u; voffB[i] = (unsigned)(Rb * K + C) * 2u; }
    const size_t kstep = (size_t)(BK * 2);
    const size_t hstep = (size_t)HALF * K * 2;
    const size_t tstep = 2 * hstep;
    const unsigned ldsw = (unsigned)wid * 1024u;
    const int aoff = lds_byte(wr * 64 + fr, fq * 8), boff = lds_byte(wc * 32 + fr, fq * 8);
#define PG8_SA(b, h) (((b) * 2 + (h)) * HTB)
#define PG8_SB(b, h) ((4 + (b) * 2 + (h)) * HTB)
#define PG8_STAGE(bufoff, gbase, voff) do { _Pragma("unroll") for (int _i = 0; _i < 2; ++_i) \
        __builtin_amdgcn_global_load_lds((const unsigned*)((const char*)(gbase) + (voff)[_i]), (PG8_LAS unsigned*)(lds + (bufoff) + ldsw + _i * 8192), 16, 0, 0); } while (0)
#define PG8_LDA(dst, b, h) do { _Pragma("unroll") for (int m = 0; m < 4; ++m) _Pragma("unroll") for (int k = 0; k < 2; ++k) dst[m][k] = *(const PG8_LAS bf16x8*)(lds + PG8_SA(b, h) + aoff + m * 2048 + k * 1024); } while (0)
#define PG8_LDB(dst, b, h) do { _Pragma("unroll") for (int n = 0; n < 2; ++n) _Pragma("unroll") for (int k = 0; k < 2; ++k) dst[n][k] = *(const PG8_LAS bf16x8*)(lds + PG8_SB(b, h) + boff + n * 2048 + k * 1024); } while (0)
#define PG8_MMA(ai, bj, At, Bt) do { __builtin_amdgcn_s_setprio(1); _Pragma("unroll") for (int m = 0; m < 4; ++m) _Pragma("unroll") for (int n = 0; n < 2; ++n) _Pragma("unroll") for (int k = 0; k < 2; ++k) \
        acc[ai][bj][m][n] = __builtin_amdgcn_mfma_f32_16x16x32_bf16(Bt[n][k], At[m][k], acc[ai][bj][m][n], 0, 0, 0); __builtin_amdgcn_s_setprio(0); } while (0)
#define PG8_WAIT_V(n) asm volatile("s_waitcnt vmcnt(" #n ")" ::: "memory")
#define PG8_WAIT_L(n) asm volatile("s_waitcnt lgkmcnt(" #n ")" ::: "memory")
#define PG8_BAR __builtin_amdgcn_s_barrier()
#define PG8_SCHED __builtin_amdgcn_sched_barrier(0)
    Unit cur, nxt; int ui = 0;
    if (!S.next(0, cur)) return;
    f32x4 acc[2][2][4][2];
#pragma unroll
    for (int a = 0; a < 2; ++a)
#pragma unroll
        for (int b = 0; b < 2; ++b)
#pragma unroll
            for (int m = 0; m < 4; ++m)
#pragma unroll
                for (int n = 0; n < 2; ++n) acc[a][b][m][n] = (f32x4){0.f, 0.f, 0.f, 0.f};
    bf16x8 At[4][2], B0[2][2], B1[2][2];
    const char* cA = (const char*)g.A + (size_t)cur.pm * tstep; const char* cB = (const char*)g.Bt + (size_t)cur.pn * tstep;
    S.a_ready(cur);
    if constexpr (SP2) {
        PG8_STAGE(PG8_SB(0, 0), cB, voffB); PG8_STAGE(PG8_SB(0, 1), cB + hstep, voffB); PG8_STAGE(PG8_SA(0, 0), cA, voffA); PG8_STAGE(PG8_SA(0, 1), cA + hstep, voffA);
        if (wr == 1) PG8_BAR;
        PG8_WAIT_V(2); PG8_BAR;
        PG8_STAGE(PG8_SB(1, 0), cB + kstep, voffB); PG8_STAGE(PG8_SA(1, 0), cA + kstep, voffA); PG8_STAGE(PG8_SB(1, 1), cB + hstep + kstep, voffB);
        PG8_WAIT_V(6); PG8_BAR;
    } else {
        PG8_STAGE(PG8_SB(0, 0), cB, voffB); PG8_STAGE(PG8_SA(0, 0), cA, voffA); PG8_STAGE(PG8_SB(0, 1), cB + hstep, voffB); PG8_STAGE(PG8_SA(0, 1), cA + hstep, voffA);
        if (wr == 1) PG8_BAR;
        PG8_WAIT_V(4); PG8_BAR;
        PG8_STAGE(PG8_SB(1, 0), cB + kstep, voffB); PG8_STAGE(PG8_SA(1, 0), cA + kstep, voffA); PG8_STAGE(PG8_SB(1, 1), cB + hstep + kstep, voffB);
        PG8_WAIT_V(6); PG8_BAR;
    }
    for (;;) {
        const bool has_next = S.next(ui + 1, nxt);
        const char* nA = has_next ? (const char*)g.A + (size_t)nxt.pm * tstep : cA; const char* nB = has_next ? (const char*)g.Bt + (size_t)nxt.pn * tstep : cB;
        for (int t = 0; t < nt; t += 2) {
            const bool last = (t == nt - 2);
            const char* a1 = cA + (size_t)(t + 1) * kstep;
            const char* a2 = last ? nA : cA + (size_t)(t + 2) * kstep; const char* b2 = last ? nB : cB + (size_t)(t + 2) * kstep;
            const char* a3 = a2 + kstep; const char* b3 = b2 + kstep;
            if (last && has_next) S.a_ready(nxt);
            if constexpr (SP2) {
            PG8_LDB(B0, 0, 0); PG8_LDB(B1, 0, 1); PG8_SCHED; PG8_LDA(At, 0, 0); PG8_STAGE(PG8_SA(1, 1), a1 + hstep, voffA);
            PG8_WAIT_V(8); PG8_WAIT_L(0); PG8_BAR; PG8_MMA(0, 0, At, B0); PG8_MMA(0, 1, At, B1); PG8_BAR; PG8_SCHED;
            PG8_LDA(At, 0, 1); PG8_STAGE(PG8_SB(0, 0), b2, voffB); PG8_STAGE(PG8_SB(0, 1), b2 + hstep, voffB); PG8_STAGE(PG8_SA(0, 0), a2, voffA);
            PG8_WAIT_V(8); PG8_WAIT_L(0); PG8_BAR; PG8_MMA(1, 0, At, B0); PG8_MMA(1, 1, At, B1); PG8_BAR; PG8_SCHED;
            PG8_LDB(B0, 1, 0); PG8_LDB(B1, 1, 1); PG8_SCHED; PG8_LDA(At, 1, 0); PG8_STAGE(PG8_SA(0, 1), a2 + hstep, voffA);
            PG8_WAIT_V(8); PG8_WAIT_L(0); PG8_BAR; PG8_MMA(0, 0, At, B0); PG8_MMA(0, 1, At, B1); PG8_BAR; PG8_SCHED;
            PG8_LDA(At, 1, 1); PG8_STAGE(PG8_SB(1, 0), b3, voffB); PG8_STAGE(PG8_SB(1, 1), b3 + hstep, voffB); PG8_STAGE(PG8_SA(1, 0), a3, voffA);
            PG8_WAIT_V(8); PG8_WAIT_L(0); PG8_BAR; PG8_MMA(1, 0, At, B0); PG8_MMA(1, 1, At, B1); PG8_BAR; PG8_SCHED;
            } else {
            PG8_LDB(B0, 0, 0); PG8_SCHED; PG8_LDA(At, 0, 0); PG8_STAGE(PG8_SA(1, 1), a1 + hstep, voffA);
            PG8_WAIT_L(8); PG8_BAR; PG8_WAIT_L(0); PG8_MMA(0, 0, At, B0); PG8_BAR; PG8_SCHED;
            PG8_LDB(B1, 0, 1); PG8_STAGE(PG8_SB(0, 0), b2, voffB);
            PG8_BAR; PG8_WAIT_L(0); PG8_MMA(0, 1, At, B1); PG8_BAR;
            PG8_LDA(At, 0, 1); PG8_STAGE(PG8_SA(0, 0), a2, voffA);
            PG8_BAR; PG8_WAIT_L(0); PG8_MMA(1, 0, At, B0); PG8_BAR; PG8_SCHED;
            PG8_STAGE(PG8_SB(0, 1), b2 + hstep, voffB);
            PG8_WAIT_V(6); PG8_BAR; PG8_MMA(1, 1, At, B1); PG8_BAR;
            PG8_LDB(B0, 1, 0); PG8_SCHED; PG8_LDA(At, 1, 0); PG8_STAGE(PG8_SA(0, 1), a2 + hstep, voffA);
            PG8_WAIT_L(8); PG8_BAR; PG8_WAIT_L(0); PG8_MMA(0, 0, At, B0); PG8_BAR; PG8_SCHED;
            PG8_LDB(B1, 1, 1); PG8_STAGE(PG8_SB(1, 0), b3, voffB);
            PG8_BAR; PG8_WAIT_L(0); PG8_MMA(0, 1, At, B1); PG8_BAR;
            PG8_LDA(At, 1, 1); PG8_STAGE(PG8_SA(1, 0), a3, voffA);
            PG8_BAR; PG8_WAIT_L(0); PG8_MMA(1, 0, At, B0); PG8_BAR; PG8_SCHED;
            PG8_STAGE(PG8_SB(1, 1), b3 + hstep, voffB);
            PG8_WAIT_V(6); PG8_BAR; PG8_MMA(1, 1, At, B1); PG8_BAR;
            }
        }
        if constexpr (ALIGN_EPI) { if (wr == 0) PG8_BAR; }
        if constexpr (!Epi::AFTER_DRAIN) { E(acc, cur, wr, wc, fr, fq); S.done(cur); }
        if (!has_next) break;
#pragma unroll
        for (int a = 0; a < 2; ++a)
#pragma unroll
            for (int b = 0; b < 2; ++b)
#pragma unroll
                for (int m = 0; m < 4; ++m)
#pragma unroll
                    for (int n = 0; n < 2; ++n) acc[a][b][m][n] = (f32x4){0.f, 0.f, 0.f, 0.f};
        cur = nxt; cA = nA; cB = nB; ++ui;
        if constexpr (ALIGN_EPI) { if (wr == 1) PG8_BAR; }
    }
    PG8_WAIT_V(0);
    if constexpr (!ALIGN_EPI) { if (wr == 0) PG8_BAR; }
    PG8_BAR;
    if constexpr (Epi::AFTER_DRAIN) { E.fused(acc, cur, wr, wc, fr, fq, lds, wid, lane); S.done(cur); }
#undef PG8_SA
#undef PG8_SB
#undef PG8_STAGE
#undef PG8_LDA
#undef PG8_LDB
#undef PG8_MMA
#undef PG8_WAIT_V
#undef PG8_WAIT_L
#undef PG8_BAR
#undef PG8_SCHED
}
}

#define LAS __attribute__((address_space(3)))
typedef unsigned short bf16;
typedef short bf16x8 __attribute__((ext_vector_type(8)));
typedef short s16x4 __attribute__((ext_vector_type(4)));
typedef float f32x4 __attribute__((ext_vector_type(4)));
typedef float f32x2 __attribute__((ext_vector_type(2)));
typedef float f32x16 __attribute__((ext_vector_type(16)));
typedef unsigned v4u __attribute__((ext_vector_type(4)));
typedef unsigned v2u __attribute__((ext_vector_type(2)));

constexpr int NWAVES = 8, NTHR = 512;
constexpr int M_TOK = 16384, SEQ = 8192, DM = 1024;
constexpr float LN_EPS = 1e-5f, RMS_EPS = 1e-5f;
constexpr float DN_ALPHA = 1.4142135623730951f;
constexpr float QSCALE = 0.08838834764831845f;
constexpr int LDS_BYTES = 147456, MISC_OFF = LDS_BYTES - 64;
constexpr size_t WS_CTL = 0, CTL_ZERO_BYTES = 65536;

constexpr size_t MiB = 1u << 20;
constexpr size_t WS_W4T = 1 * MiB, WS_LSE = 3 * MiB, WS_W3T = 4 * MiB, WS_COS = 15 * MiB, WS_SIN = 17 * MiB, WS_X1B = 19 * MiB;
constexpr size_t WS_W1T = 19 * MiB, WS_W2T = 25 * MiB, WS_ALR = 27 * MiB, WS_BEND = 28 * MiB, WS_SST = 29 * MiB;
constexpr size_t WS_OATT = 4 * MiB, WS_QKVG = 68 * MiB, WS_Q = 68 * MiB, WS_V1 = 68 * MiB, WS_XB = 164 * MiB, WS_SLOC = 164 * MiB, WS_OG = 164 * MiB;
constexpr size_t WS_K = 164 * MiB, WS_V = 188 * MiB, WS_G = 212 * MiB, WS_END = 244 * MiB;

struct Params {
    const float *x, *gla_w_in, *gla_w_a2, *gla_b_a2, *gla_norm_g, *gla_w_out, *w_kv, *swa_w_in, *swa_w_out, *ln_g, *ln_b;
    float* out; unsigned char* ws;
    float inv_freq[64];
    int ph_lo, ph_hi;
};

__device__ __forceinline__ unsigned f2bf(float f) { unsigned u = __builtin_bit_cast(unsigned, f); return (u + 0x7fffu + ((u >> 16) & 1u)) >> 16; }
__device__ __forceinline__ unsigned pk2(float lo, float hi) { return f2bf(lo) | (f2bf(hi) << 16); }
__device__ __forceinline__ float bflo(unsigned w) { return __builtin_bit_cast(float, w << 16); }
__device__ __forceinline__ float bfhi(unsigned w) { return __builtin_bit_cast(float, w & 0xffff0000u); }
__device__ __forceinline__ float wave_sum(float v) {
#pragma unroll
    for (int o = 1; o < 64; o <<= 1) v += __shfl_xor(v, o);
    return v;
}
#define LDS_WAIT() asm volatile("s_waitcnt lgkmcnt(0)" ::: "memory")


#define XB_TMO      128
#define XB_XCNT(j)  (256  + 64 * (j))
#define XB_XSUB(j)  (1280 + 64 * (j))
#define XB_XGEN(j)  (2304 + 64 * (j))
#define XB_TOP      3328
#define XB_TOPGEN   3392
#define XCD_BAR_WORDS 3456
#define XB_SPIN_CAP (1u << 18)

__device__ __forceinline__ unsigned xb_ld(unsigned* p)              { return __hip_atomic_load(p, __ATOMIC_RELAXED, __HIP_MEMORY_SCOPE_AGENT); }
__device__ __forceinline__ unsigned xb_add(unsigned* p, unsigned v) { return __hip_atomic_fetch_add(p, v, __ATOMIC_RELAXED, __HIP_MEMORY_SCOPE_AGENT); }
__device__ __forceinline__ unsigned xb_xcc_id() { return (unsigned)__builtin_amdgcn_s_getreg((3 << 11) | 20) & 0xFu; }
#define XB_SPIN(cond, bar) do { unsigned _sp = 0; while (cond) { __builtin_amdgcn_s_sleep(1); \
    if ((++_sp & 255u) == 0u) { if (xb_ld(&(bar)[XB_TMO])) break; if (_sp > XB_SPIN_CAP) { atomicAdd(&(bar)[XB_TMO], 1u); break; } } } } while (0)

struct XcdBarrier {
    unsigned* bar; unsigned x;
    volatile LAS unsigned* st;
};

__device__ __forceinline__ XcdBarrier xcd_barrier_post(unsigned* bar, volatile LAS unsigned* st) {
    XcdBarrier b; b.bar = bar; b.x = xb_xcc_id(); b.st = st;
    if (threadIdx.x == 0) (void)xb_add(&bar[XB_XCNT(b.x)], 1u);
    return b;
}
__device__ __forceinline__ void xcd_barrier_complete(unsigned* bar, unsigned x, unsigned& nloc, unsigned& nx) {
    const unsigned G = gridDim.x * gridDim.y * gridDim.z;
    unsigned sum, cnt, mine, sp = 0u;
    for (;;) {
        sum = 0u; cnt = 0u; mine = 0u;
#pragma unroll
        for (unsigned j = 0; j < 16; ++j) { const unsigned c = xb_ld(&bar[XB_XCNT(j)]); sum += c; cnt += (c > 0u) ? 1u : 0u; mine = (j == x) ? c : mine; }
        if (sum == G) break;
        __builtin_amdgcn_s_sleep(1);
        if ((++sp & 255u) == 0u) { if (xb_ld(&bar[XB_TMO])) break; if (sp > XB_SPIN_CAP) { atomicAdd(&bar[XB_TMO], 1u); break; } }
    }
    nloc = mine > 0u ? mine : 1u; nx = cnt > 0u ? cnt : 1u;
}

__device__ __forceinline__ void xcd_barrier(const XcdBarrier& b) {
    asm volatile("s_waitcnt vmcnt(0)" ::: "memory");
    __syncthreads();
    if (threadIdx.x == 0) {
        unsigned* bar = b.bar;
        __builtin_amdgcn_s_waitcnt(0);
        unsigned nloc = b.st[0], nx = b.st[1];
        if (nloc == 0u) { xcd_barrier_complete(bar, b.x, nloc, nx); b.st[0] = nloc; b.st[1] = nx; }
        const unsigned old = xb_add(&bar[XB_XSUB(b.x)], 1u);
        const unsigned gen = old / nloc;
        if (old + 1u == (gen + 1u) * nloc) {
            __builtin_amdgcn_fence(__ATOMIC_RELEASE, "agent");
            asm volatile("s_waitcnt vmcnt(0)" ::: "memory");
            const unsigned og = xb_add(&bar[XB_TOP], 1u);
            const unsigned tg = og / nx;
            if (og + 1u == (tg + 1u) * nx) xb_add(&bar[XB_TOPGEN], 1u);
            else XB_SPIN(xb_ld(&bar[XB_TOPGEN]) == tg, bar);
            __builtin_amdgcn_fence(__ATOMIC_ACQUIRE, "agent");
            xb_add(&bar[XB_XGEN(b.x)], 1u);
            asm volatile("s_waitcnt vmcnt(0)" ::: "memory");
        } else {
            XB_SPIN(xb_ld(&bar[XB_XGEN(b.x)]) == gen, bar);
            __builtin_amdgcn_fence(__ATOMIC_ACQUIRE, "agent");
            asm volatile("s_waitcnt vmcnt(0)" ::: "memory");
        }
    }
    __syncthreads();
}

template <bool ROPEPERM>
__device__ __forceinline__ void p0_transpose_item(const float* W, int K, int ldw, int ncols, bf16* WT, int row_off, LAS float* scr, int item, int lane) {
    const int nblk = ncols / 32, kb = item / nblk, nb = item % nblk, k0 = 64 * kb, n0 = 32 * nb;
#pragma unroll 8
    for (int i = 0; i < 32; ++i) { const int kk = 2 * i + (lane >> 5); scr[kk * 33 + (lane & 31)] = W[(size_t)(k0 + kk) * ldw + n0 + (lane & 31)]; }
    LDS_WAIT(); asm volatile("" ::: "memory");
    const int c = lane & 7;
#pragma unroll
    for (int j = 0; j < 4; ++j) { const int n = (lane >> 3) + 8 * j; const LAS float* s = scr + (8 * c) * 33 + n;
        v4u o; o.x = pk2(s[0 * 33], s[1 * 33]); o.y = pk2(s[2 * 33], s[3 * 33]); o.z = pk2(s[4 * 33], s[5 * 33]); o.w = pk2(s[6 * 33], s[7 * 33]);
        int nd = n0 + n;
        if (ROPEPERM) { const int dim = nd & 127; const int cp = (dim < 64) ? ((dim >> 2) * 8 + (dim & 3)) : (((dim - 64) >> 2) * 8 + 4 + (dim & 3)); nd = (nd & ~127) + cp; }
        *(v4u*)(WT + (size_t)(row_off + nd) * K + k0 + 8 * c) = o; }
    LDS_WAIT(); asm volatile("" ::: "memory");
}

__device__ __forceinline__ void p0_prologue(const Params& p, LAS unsigned char* lds, int tid, int lane, int wave, int G) {
    unsigned char* ws = p.ws;
    const int gw = blockIdx.x * NWAVES + wave, NGW = G * NWAVES;
    {
        LAS float* scr = (LAS float*)(lds + wave * 16384);
        constexpr int I1 = 16 * 96, I2 = 16 * 32, I3K = 16 * 24, I3V = 16 * 24, I3Q = 16 * 96, I3G = 16 * 32, I4 = 16 * 32;
        constexpr int NIT = I1 + I2 + I3K + I3V + I3Q + I3G + I4;
        bf16* W1T = (bf16*)(ws + WS_W1T); bf16* W2T = (bf16*)(ws + WS_W2T); bf16* W3T = (bf16*)(ws + WS_W3T); bf16* W4T = (bf16*)(ws + WS_W4T);
        for (int it = gw; it < NIT; it += NGW) {
            int r = it;
            if (r < I1) { p0_transpose_item<false>(p.gla_w_in, 1024, 3088, 3072, W1T, 0, scr, r, lane); continue; } r -= I1;
            if (r < I2) { p0_transpose_item<false>(p.gla_w_out, 1024, 1024, 1024, W2T, 0, scr, r, lane); continue; } r -= I2;
            if (r < I3K) { p0_transpose_item<true>(p.w_kv, 1024, 1536, 768, W3T, 0, scr, r, lane); continue; } r -= I3K;
            if (r < I3V) { p0_transpose_item<false>(p.w_kv + 768, 1024, 1536, 768, W3T, 768, scr, r, lane); continue; } r -= I3V;
            if (r < I3Q) { p0_transpose_item<true>(p.swa_w_in, 1024, 4096, 3072, W3T, 1536, scr, r, lane); continue; } r -= I3Q;
            if (r < I3G) { p0_transpose_item<false>(p.swa_w_in + 3072, 1024, 4096, 1024, W3T, 1536 + 3072, scr, r, lane); continue; } r -= I3G;
            p0_transpose_item<false>(p.swa_w_out, 1024, 1024, 1024, W4T, 0, scr, r, lane);
        }
    }
    __syncthreads();
    {
        float* cosT = (float*)(ws + WS_COS); float* sinT = (float*)(ws + WS_SIN);
        for (int e = blockIdx.x * NTHR + tid; e < SEQ * 64; e += G * NTHR) {
            const int pos = e >> 6, i = e & 63;
            const float angf = (float)pos * p.inv_freq[i];
            double rev = (double)angf * 0.15915494309189535; rev -= floor(rev);
            const float rf = (float)rev;
            cosT[e] = __builtin_amdgcn_cosf(rf); sinT[e] = __builtin_amdgcn_sinf(rf);
        }
    }
    {
        LAS float* WaT = (LAS float*)lds;
        for (int i = tid; i < 1024 * 4; i += NTHR) { const int k = i >> 2, r4 = (i & 3) * 4;
            const f32x4 w = *(const f32x4*)(p.gla_w_in + (size_t)k * 3088 + 3072 + r4);
            WaT[(r4 + 0) * 1024 + k] = w[0]; WaT[(r4 + 1) * 1024 + k] = w[1]; WaT[(r4 + 2) * 1024 + k] = w[2]; WaT[(r4 + 3) * 1024 + k] = w[3]; }
        __syncthreads();
        bf16* XB = (bf16*)(ws + WS_XB); float* ALR = (float*)(ws + WS_ALR);
        for (int row = gw; row < M_TOK; row += NGW) {
            const f32x4* xr = (const f32x4*)(p.x + (size_t)row * DM) + lane;
            f32x4 v[4];
#pragma unroll
            for (int j = 0; j < 4; ++j) v[j] = xr[64 * j];
            unsigned long long* o8 = (unsigned long long*)(XB + (size_t)row * DM) + lane;
#pragma unroll
            for (int j = 0; j < 4; ++j) o8[64 * j] = (unsigned long long)pk2(v[j][0], v[j][1]) | ((unsigned long long)pk2(v[j][2], v[j][3]) << 32);
            float outv = 0.f;
#pragma unroll 2
            for (int r = 0; r < 16; ++r) {
                float a = 0.f;
#pragma unroll
                for (int j = 0; j < 4; ++j) { const f32x4 w = *(const LAS f32x4*)(WaT + r * 1024 + 256 * j + 4 * lane);
                    a += v[j][0] * w[0] + v[j][1] * w[1] + v[j][2] * w[2] + v[j][3] * w[3]; }
                a = wave_sum(a);
                outv = (lane == r) ? a : outv;
            }
            if (lane < 16) ALR[(size_t)row * 16 + lane] = outv;
        }
        __syncthreads();
    }
}

template <bool WB>
__device__ __forceinline__ void ln_rows(const float* V, float* outF, bf16* outB, const float* g, const float* b, int lane, int wave, int G) {
    const int gw = blockIdx.x * NWAVES + wave, NGW = G * NWAVES;
    f32x4 gv[4], bv[4];
#pragma unroll
    for (int j = 0; j < 4; ++j) { gv[j] = *((const f32x4*)g + lane + 64 * j); bv[j] = *((const f32x4*)b + lane + 64 * j); }
    for (int row = gw; row < M_TOK; row += NGW) {
        const f32x4* xr = (const f32x4*)(V + (size_t)row * DM) + lane;
        f32x4 v[4]; float s = 0.f;
#pragma unroll
        for (int j = 0; j < 4; ++j) { v[j] = xr[64 * j]; s += (v[j][0] + v[j][1]) + (v[j][2] + v[j][3]); }
        const float mean = wave_sum(s) * (1.f / DM); float s2 = 0.f;
#pragma unroll
        for (int j = 0; j < 4; ++j) { v[j] = v[j] - mean; s2 += (v[j][0] * v[j][0] + v[j][1] * v[j][1]) + (v[j][2] * v[j][2] + v[j][3] * v[j][3]); }
        const float rstd = 1.f / sqrtf(wave_sum(s2) * (1.f / DM) + LN_EPS);
        f32x4* of = (f32x4*)(outF + (size_t)row * DM) + lane;
        unsigned long long* o8 = (unsigned long long*)(outB + (size_t)row * DM) + lane;
#pragma unroll
        for (int j = 0; j < 4; ++j) { const f32x4 o = v[j] * rstd * gv[j] + bv[j]; of[64 * j] = o;
            if (WB) o8[64 * j] = (unsigned long long)pk2(o[0], o[1]) | ((unsigned long long)pk2(o[2], o[3]) << 32); }
    }
}

constexpr int GL_ROW = 272;
constexpr int GL_QS = 0, GL_KS = 34816, GL_VT = 69632, GL_TOT = 139264, GL_SSQ = GL_TOT + 4096, GL_ALR = GL_VT;
constexpr int GL_KT = 0;

__device__ __forceinline__ float log_sigmoid_f(float x) { return fminf(x, 0.f) - __logf(1.f + __expf(-fabsf(x))); }

__device__ __forceinline__ void gla_decay(const Params& p, LAS unsigned char* lds, int tok0, int hh, int tid, int lane, int wave, float (&cl)[16][2], float (&bend)[2]) {
    const float* ALR = (const float*)(p.ws + WS_ALR);
    LAS f32x4* alrs = (LAS f32x4*)(lds + GL_ALR);
    alrs[tid] = *((const f32x4*)(ALR + (size_t)tok0 * 16) + tid);
    float wa[16][2];
#pragma unroll
    for (int r = 0; r < 16; ++r) { const f32x2 w = *(const f32x2*)(p.gla_w_a2 + r * 512 + hh * 128 + 2 * lane); wa[r][0] = w[0]; wa[r][1] = w[1]; }
    const f32x2 ba = *(const f32x2*)(p.gla_b_a2 + hh * 128 + 2 * lane);
    __syncthreads();
    float run0 = 0.f, run1 = 0.f;
#pragma unroll
    for (int tt = 0; tt < 16; ++tt) {
        const int t = 16 * wave + tt;
        float x0 = ba[0], x1 = ba[1];
#pragma unroll
        for (int q4 = 0; q4 < 4; ++q4) { const f32x4 a = alrs[t * 4 + q4];
#pragma unroll
            for (int e = 0; e < 4; ++e) { x0 += a[e] * wa[q4 * 4 + e][0]; x1 += a[e] * wa[q4 * 4 + e][1]; } }
        run0 += log_sigmoid_f(x0) * (1.f / 16.f); run1 += log_sigmoid_f(x1) * (1.f / 16.f);
        cl[tt][0] = run0; cl[tt][1] = run1;
    }
    LAS f32x2* tots = (LAS f32x2*)(lds + GL_TOT);
    tots[wave * 64 + lane] = (f32x2){run0, run1};
    __syncthreads();
    float off0 = 0.f, off1 = 0.f, e0 = 0.f, e1 = 0.f;
#pragma unroll
    for (int g = 0; g < 8; ++g) { const f32x2 tv = tots[g * 64 + lane]; if (g < wave) { off0 += tv[0]; off1 += tv[1]; } e0 += tv[0]; e1 += tv[1]; }
#pragma unroll
    for (int tt = 0; tt < 16; ++tt) { cl[tt][0] += off0; cl[tt][1] += off1; }
    bend[0] = e0; bend[1] = e1;
}

__device__ __forceinline__ void gla_load_vt(const bf16* QKVG, LAS unsigned char* lds, int tok0, int hh, int tid) {
    const int dp = tid & 127, tg = tid >> 7;
    const unsigned* src = (const unsigned*)(QKVG + (size_t)(tok0 + 32 * tg) * 3072 + 1024 + hh * 256 + 2 * dp);
#pragma unroll
    for (int g8 = 0; g8 < 4; ++g8) {
        unsigned ld[8];
#pragma unroll
        for (int i = 0; i < 8; ++i) ld[i] = src[(size_t)(g8 * 8 + i) * 1536];
        v4u c0, c1;
#pragma unroll
        for (int i = 0; i < 4; ++i) { c0[i] = (ld[2 * i] & 0xffffu) | (ld[2 * i + 1] << 16); c1[i] = (ld[2 * i] >> 16) | (ld[2 * i + 1] & 0xffff0000u); }
        *(LAS v4u*)(lds + GL_VT + (2 * dp) * GL_ROW + (32 * tg + 8 * g8) * 2) = c0;
        *(LAS v4u*)(lds + GL_VT + (2 * dp + 1) * GL_ROW + (32 * tg + 8 * g8) * 2) = c1;
    }
}

__device__ __forceinline__ void gla_pass_a(const Params& p, LAS unsigned char* lds, int tid, int lane, int wave, int G) {
    const bf16* QKVG = (const bf16*)(p.ws + WS_QKVG); float* SLOC = (float*)(p.ws + WS_SLOC); float* BEND = (float*)(p.ws + WS_BEND);
    const int l32 = lane & 31, hf = lane >> 5;
    for (int task = blockIdx.x; task < 512; task += G) {
        const int bh = task >> 6, sc = task & 63, bb = bh >> 2, hh = bh & 3;
        const int tok0 = bb * SEQ + sc * 128;
        float cl[16][2], bend[2];
        gla_decay(p, lds, tok0, hh, tid, lane, wave, cl, bend);
        if (wave == 0) *(f32x2*)(BEND + (size_t)task * 128 + 2 * lane) = (f32x2){bend[0], bend[1]};
        {
            const unsigned* ksrc = (const unsigned*)(QKVG + (size_t)(tok0 + 16 * wave) * 3072 + 512 + hh * 128 + 2 * lane);
            unsigned kv[16];
#pragma unroll
            for (int tt = 0; tt < 16; ++tt) kv[tt] = ksrc[(size_t)tt * 1536];
            float k0[16], k1[16];
#pragma unroll
            for (int tt = 0; tt < 16; ++tt) { k0[tt] = bflo(kv[tt]) * __expf(bend[0] - cl[tt][0]); k1[tt] = bfhi(kv[tt]) * __expf(bend[1] - cl[tt][1]); }
#pragma unroll
            for (int h8 = 0; h8 < 2; ++h8) { v4u c0, c1;
#pragma unroll
                for (int i = 0; i < 4; ++i) { c0[i] = pk2(k0[h8 * 8 + 2 * i], k0[h8 * 8 + 2 * i + 1]); c1[i] = pk2(k1[h8 * 8 + 2 * i], k1[h8 * 8 + 2 * i + 1]); }
                *(LAS v4u*)(lds + GL_KT + (2 * lane) * GL_ROW + (16 * wave + 8 * h8) * 2) = c0;
                *(LAS v4u*)(lds + GL_KT + (2 * lane + 1) * GL_ROW + (16 * wave + 8 * h8) * 2) = c1; }
        }
        gla_load_vt(QKVG, lds, tok0, hh, tid);
        __syncthreads();
        f32x16 acc[4];
#pragma unroll
        for (int j = 0; j < 4; ++j)
#pragma unroll
            for (int r = 0; r < 16; ++r) acc[j][r] = 0.f;
#pragma unroll
        for (int s = 0; s < 8; ++s) {
            const bf16x8 a = *(const LAS bf16x8*)(lds + GL_VT + (32 * wave + l32) * GL_ROW + (16 * s + 8 * hf) * 2);
#pragma unroll
            for (int j = 0; j < 4; ++j) { const bf16x8 b = *(const LAS bf16x8*)(lds + GL_KT + (32 * j + l32) * GL_ROW + (16 * s + 8 * hf) * 2);
                acc[j] = __builtin_amdgcn_mfma_f32_32x32x16_bf16(a, b, acc[j], 0, 0, 0); }
        }
        float* dst = SLOC + (size_t)task * 32768;
#pragma unroll
        for (int j = 0; j < 4; ++j)
#pragma unroll
            for (int r = 0; r < 16; ++r) { const int dv = 32 * wave + (r & 3) + 8 * (r >> 2) + 4 * hf; dst[dv * 128 + 32 * j + l32] = acc[j][r]; }
        __syncthreads();
    }
}

__device__ __forceinline__ void gla_pass_b(const Params& p, int tid, int G) {
    const float* SLOC = (const float*)(p.ws + WS_SLOC); const float* BEND = (const float*)(p.ws + WS_BEND); bf16* SST = (bf16*)(p.ws + WS_SST);
    for (int e = blockIdx.x * NTHR + tid; e < 8 * 32768; e += G * NTHR) {
        const int bh = e >> 15, el = e & 32767, dk = el & 127;
        float s = 0.f;
        for (int sc0 = 0; sc0 < 64; sc0 += 8) {
            float lv[8], dc[8];
#pragma unroll
            for (int i = 0; i < 8; ++i) { lv[i] = SLOC[(size_t)(bh * 64 + sc0 + i) * 32768 + el]; dc[i] = BEND[(bh * 64 + sc0 + i) * 128 + dk]; }
#pragma unroll
            for (int i = 0; i < 8; ++i) { SST[(size_t)(bh * 64 + sc0 + i) * 32768 + el] = (bf16)f2bf(s); s = s * __expf(dc[i]) + lv[i]; }
        }
    }
}

__device__ __forceinline__ void gla_pass_c(const Params& p, LAS unsigned char* lds, int tid, int lane, int wave, int G) {
    const bf16* QKVG = (const bf16*)(p.ws + WS_QKVG); const bf16* SST = (const bf16*)(p.ws + WS_SST); bf16* OG = (bf16*)(p.ws + WS_OG);
    const int l32 = lane & 31, hf = lane >> 5;
    const int ts = wave & 3, dh = wave >> 2;
    for (int task = blockIdx.x; task < 512; task += G) {
        const int bh = task >> 6, sc = task & 63, bb = bh >> 2, hh = bh & 3;
        const int tok0 = bb * SEQ + sc * 128;
        {
            float cl[16][2], bend[2];
            gla_decay(p, lds, tok0, hh, tid, lane, wave, cl, bend);
            const unsigned* qsrc = (const unsigned*)(QKVG + (size_t)(tok0 + 16 * wave) * 3072 + hh * 128 + 2 * lane);
            const unsigned* ksrc = qsrc + 256;
            unsigned qv[16], kv[16];
#pragma unroll
            for (int tt = 0; tt < 16; ++tt) { qv[tt] = qsrc[(size_t)tt * 1536]; kv[tt] = ksrc[(size_t)tt * 1536]; }
#pragma unroll
            for (int tt = 0; tt < 16; ++tt) {
                const float e0 = __expf(cl[tt][0]), e1 = __expf(cl[tt][1]), n0 = __expf(-cl[tt][0]), n1 = __expf(-cl[tt][1]);
                *(LAS unsigned*)(lds + GL_QS + (16 * wave + tt) * GL_ROW + 4 * lane) = pk2(bflo(qv[tt]) * e0, bfhi(qv[tt]) * e1);
                *(LAS unsigned*)(lds + GL_KS + (16 * wave + tt) * GL_ROW + 4 * lane) = pk2(bflo(kv[tt]) * n0, bfhi(kv[tt]) * n1);
            }
        }
        gla_load_vt(QKVG, lds, tok0, hh, tid);
        __syncthreads();
        bf16x8 qf[8];
#pragma unroll
        for (int s = 0; s < 8; ++s) qf[s] = *(const LAS bf16x8*)(lds + GL_QS + (32 * ts + l32) * GL_ROW + (16 * s + 8 * hf) * 2);
        f32x16 O[4];
#pragma unroll
        for (int j = 0; j < 4; ++j)
#pragma unroll
            for (int r = 0; r < 16; ++r) O[j][r] = 0.f;
        {
            const bf16* st = SST + (size_t)task * 32768;
#pragma unroll
            for (int dt = 0; dt < 4; ++dt) {
                const bf16* srow = st + (size_t)(128 * dh + 32 * dt + l32) * 128 + 8 * hf;
#pragma unroll
                for (int s = 0; s < 8; ++s) { const bf16x8 a = *(const bf16x8*)(srow + 16 * s); O[dt] = __builtin_amdgcn_mfma_f32_32x32x16_bf16(a, qf[s], O[dt], 0, 0, 0); }
            }
        }
        for (int jb = 0; jb <= ts; ++jb) {
            f32x16 att;
#pragma unroll
            for (int r = 0; r < 16; ++r) att[r] = 0.f;
#pragma unroll
            for (int s = 0; s < 8; ++s) { const bf16x8 a = *(const LAS bf16x8*)(lds + GL_KS + (32 * jb + l32) * GL_ROW + (16 * s + 8 * hf) * 2);
                att = __builtin_amdgcn_mfma_f32_32x32x16_bf16(a, qf[s], att, 0, 0, 0); }
            if (jb == ts) {
#pragma unroll
                for (int r = 0; r < 16; ++r) { const int row = (r & 3) + 8 * (r >> 2) + 4 * hf; att[r] = (row <= l32) ? att[r] : 0.f; }
            }
            bf16x8 pf[2];
#pragma unroll
            for (int s2 = 0; s2 < 2; ++s2) { v4u w;
#pragma unroll
                for (int i = 0; i < 4; ++i) w[i] = pk2(att[8 * s2 + 2 * i], att[8 * s2 + 2 * i + 1]);
                pf[s2] = __builtin_bit_cast(bf16x8, w); }
#pragma unroll
            for (int dt = 0; dt < 4; ++dt) {
                const LAS unsigned char* vrow = lds + GL_VT + (128 * dh + 32 * dt + l32) * GL_ROW + (32 * jb + 4 * hf) * 2;
#pragma unroll
                for (int s2 = 0; s2 < 2; ++s2) {
                    const v2u lo = *(const LAS v2u*)(vrow + (16 * s2) * 2), hi = *(const LAS v2u*)(vrow + (16 * s2 + 8) * 2);
                    const v4u av = (v4u){lo[0], lo[1], hi[0], hi[1]};
                    O[dt] = __builtin_amdgcn_mfma_f32_32x32x16_bf16(__builtin_bit_cast(bf16x8, av), pf[s2], O[dt], 0, 0, 0);
                }
            }
        }
        float ssq = 0.f;
#pragma unroll
        for (int dt = 0; dt < 4; ++dt)
#pragma unroll
            for (int r = 0; r < 16; ++r) ssq += O[dt][r] * O[dt][r];
        ssq += __shfl_xor(ssq, 32);
        LAS float* ssqs = (LAS float*)(lds + GL_SSQ);
        if (hf == 0) ssqs[dh * 128 + 32 * ts + l32] = ssq;
        __syncthreads();
        const float tot = ssqs[32 * ts + l32] + ssqs[128 + 32 * ts + l32];
        const float rstd = 1.f / sqrtf(tot * (1.f / 256.f) + RMS_EPS);
        const size_t trow = (size_t)(tok0 + 32 * ts + l32);
#pragma unroll
        for (int dt = 0; dt < 4; ++dt)
#pragma unroll
            for (int rq = 0; rq < 4; ++rq) {
                const int dv = 128 * dh + 32 * dt + 8 * rq + 4 * hf;
                const v2u gw2 = *(const v2u*)(QKVG + trow * 3072 + 2048 + hh * 256 + dv);
                const f32x4 ng = *(const f32x4*)(p.gla_norm_g + hh * 256 + dv);
                float gv[4] = {bflo(gw2[0]), bfhi(gw2[0]), bflo(gw2[1]), bfhi(gw2[1])};
                float ov[4];
#pragma unroll
                for (int e = 0; e < 4; ++e) { const float gg = gv[e]; const float sl = gg / (1.f + __expf(-gg)); ov[e] = O[dt][4 * rq + e] * rstd * ng[e] * sl; }
                v2u ow; ow[0] = pk2(ov[0], ov[1]); ow[1] = pk2(ov[2], ov[3]);
                *(v2u*)(OG + trow * 1024 + hh * 256 + dv) = ow;
            }
        __syncthreads();
    }
}

constexpr int AT_KROW = 272, AT_VROW = 528;
constexpr int AT_KS = 0, AT_VT = 256 * AT_KROW;
template <bool MERGE>
__device__ __forceinline__ void attn_phase(const Params& p, LAS unsigned char* lds, int tid, int lane, int wave, int G) {
    const bf16* Kb = (const bf16*)(p.ws + WS_K); const bf16* Vb = (const bf16*)(p.ws + WS_V); const bf16* Qb = (const bf16*)(p.ws + WS_Q);
    bf16* Gb = (bf16*)(p.ws + WS_G); bf16* OATT = (bf16*)(p.ws + WS_OATT); float* LSE = (float*)(p.ws + WS_LSE);
    const int l32 = lane & 31, hf = lane >> 5;
    const int ntask = MERGE ? 256 : 512;
    for (int task = blockIdx.x; task < ntask; task += G) {
        int g, bb, kvh, blk;
        if (MERGE) { g = 0; bb = task >> 7; kvh = (task >> 6) & 1; blk = task & 63; }
        else { g = 1 + (task >> 8); bb = (task >> 7) & 1; kvh = (task >> 6) & 1; blk = task & 63; }
        const int dil = (g == 0) ? 1 : (g == 1 ? 4 : 16);
        const int nb = 64 / dil;
        const int rr = blk / nb, n = blk % nb;
        const int kvcol = (g * 2 + kvh) * 128;
        for (int id = tid; id < 256 * 16; id += NTHR) {
            const int row = id >> 4, ch = id & 15;
            v4u val = (v4u){0u, 0u, 0u, 0u};
            if (n > 0 || row >= 128) { const int tok = ((n - 1) * 128 + row) * dil + rr; val = *(const v4u*)(Kb + (size_t)(bb * SEQ + tok) * 768 + kvcol + ch * 8); }
            *(LAS v4u*)(lds + AT_KS + row * AT_KROW + ch * 16) = val;
        }
        {
#pragma unroll
            for (int g8 = 0; g8 < 4; ++g8) {
                unsigned ld[8];
#pragma unroll
                for (int i = 0; i < 8; ++i) { const int row = 32 * wave + 8 * g8 + i; unsigned vv = 0u;
                    if (n > 0 || row >= 128) { const int tok = ((n - 1) * 128 + row) * dil + rr; vv = *(const unsigned*)(Vb + (size_t)(bb * SEQ + tok) * 768 + kvcol + 2 * lane); }
                    ld[i] = vv; }
                v4u c0, c1;
#pragma unroll
                for (int i = 0; i < 4; ++i) { c0[i] = (ld[2 * i] & 0xffffu) | (ld[2 * i + 1] << 16); c1[i] = (ld[2 * i] >> 16) | (ld[2 * i + 1] & 0xffff0000u); }
                *(LAS v4u*)(lds + AT_VT + (2 * lane) * AT_VROW + (32 * wave + 8 * g8) * 2) = c0;
                *(LAS v4u*)(lds + AT_VT + (2 * lane + 1) * AT_VROW + (32 * wave + 8 * g8) * 2) = c1;
            }
        }
        __syncthreads();
        for (int it = 0; it < 2; ++it) {
            const int job = it * 8 + wave, hq = job >> 2, qs = job & 3;
            const int head = kvh * 4 + hq;
            const int qtok = bb * SEQ + (n * 128 + 32 * qs + l32) * dil + rr;
            bf16x8 qf[8];
            {
                const bf16* qrow = Qb + (size_t)qtok * 3072 + (g * 8 + head) * 128 + 8 * hf;
#pragma unroll
                for (int s = 0; s < 8; ++s) qf[s] = *(const bf16x8*)(qrow + 16 * s);
            }
            f32x16 sc[5];
#pragma unroll
            for (int kt = 0; kt < 5; ++kt) {
#pragma unroll
                for (int r = 0; r < 16; ++r) sc[kt][r] = 0.f;
                const LAS unsigned char* krow = lds + AT_KS + (32 * (qs + kt) + l32) * AT_KROW + 16 * hf;
#pragma unroll
                for (int s = 0; s < 8; ++s) { const bf16x8 a = *(const LAS bf16x8*)(krow + 32 * s); sc[kt] = __builtin_amdgcn_mfma_f32_32x32x16_bf16(a, qf[s], sc[kt], 0, 0, 0); }
                __builtin_amdgcn_sched_barrier(0);
            }
            const float NEG = -1e30f;
            float mx = NEG;
#pragma unroll
            for (int kt = 0; kt < 5; ++kt) {
                const bool tile_ok = (n > 0) || (qs + kt >= 4);
#pragma unroll
                for (int r = 0; r < 16; ++r) { const int row = (r & 3) + 8 * (r >> 2) + 4 * hf;
                    bool ok = tile_ok;
                    if (kt == 0) ok = ok && (row >= l32);
                    if (kt == 4) ok = ok && (row <= l32);
                    const float v = ok ? sc[kt][r] : NEG; sc[kt][r] = v; mx = fmaxf(mx, v); }
            }
            mx = fmaxf(mx, __shfl_xor(mx, 32));
            float den = 0.f;
#pragma unroll
            for (int kt = 0; kt < 5; ++kt)
#pragma unroll
                for (int r = 0; r < 16; ++r) { const float e = __expf(sc[kt][r] - mx); sc[kt][r] = e; den += e; }
            den += __shfl_xor(den, 32);
            f32x16 O[4];
#pragma unroll
            for (int j = 0; j < 4; ++j)
#pragma unroll
                for (int r = 0; r < 16; ++r) O[j][r] = 0.f;
#pragma unroll
            for (int kt = 0; kt < 5; ++kt) {
                bf16x8 pf[2];
#pragma unroll
                for (int s2 = 0; s2 < 2; ++s2) { v4u w;
#pragma unroll
                    for (int i = 0; i < 4; ++i) w[i] = pk2(sc[kt][8 * s2 + 2 * i], sc[kt][8 * s2 + 2 * i + 1]);
                    pf[s2] = __builtin_bit_cast(bf16x8, w); }
#pragma unroll
                for (int dt = 0; dt < 4; ++dt) {
                    const LAS unsigned char* vrow = lds + AT_VT + (32 * dt + l32) * AT_VROW + (32 * (qs + kt) + 4 * hf) * 2;
#pragma unroll
                    for (int s2 = 0; s2 < 2; ++s2) {
                        const v2u lo = *(const LAS v2u*)(vrow + (16 * s2) * 2), hi = *(const LAS v2u*)(vrow + (16 * s2 + 8) * 2);
                        const v4u av = (v4u){lo[0], lo[1], hi[0], hi[1]};
                        O[dt] = __builtin_amdgcn_mfma_f32_32x32x16_bf16(__builtin_bit_cast(bf16x8, av), pf[s2], O[dt], 0, 0, 0);
                    }
                    __builtin_amdgcn_sched_barrier(0);
                }
            }
            const float inv = 1.f / den;
            const float lse = mx + __logf(den);
            if (!MERGE) {
                bf16* orow = OATT + (size_t)(g - 1) * M_TOK * 1024 + (size_t)qtok * 1024 + head * 128;
#pragma unroll
                for (int dt = 0; dt < 4; ++dt)
#pragma unroll
                    for (int rq = 0; rq < 4; ++rq) { const int dv = 32 * dt + 8 * rq + 4 * hf;
                        v2u ow; ow[0] = pk2(O[dt][4 * rq] * inv, O[dt][4 * rq + 1] * inv); ow[1] = pk2(O[dt][4 * rq + 2] * inv, O[dt][4 * rq + 3] * inv);
                        *(v2u*)(orow + dv) = ow; }
                if (hf == 0) LSE[(size_t)(g - 1) * M_TOK * 8 + (size_t)qtok * 8 + head] = lse;
            } else {
                const float l1 = LSE[(size_t)qtok * 8 + head], l2 = LSE[(size_t)M_TOK * 8 + (size_t)qtok * 8 + head];
                const float mm = fmaxf(lse, fmaxf(l1, l2));
                const float e0 = __expf(lse - mm), e1 = __expf(l1 - mm), e2 = __expf(l2 - mm);
                const float rs = 1.f / (e0 + e1 + e2);
                const float w0 = e0 * rs * inv, w1 = e1 * rs, w2 = e2 * rs;
                const bf16* o1row = OATT + (size_t)qtok * 1024 + head * 128;
                const bf16* o2row = o1row + (size_t)M_TOK * 1024;
                bf16* grow = Gb + (size_t)qtok * 1024 + head * 128;
#pragma unroll
                for (int dt = 0; dt < 4; ++dt)
#pragma unroll
                    for (int rq = 0; rq < 4; ++rq) { const int dv = 32 * dt + 8 * rq + 4 * hf;
                        const v2u a1 = *(const v2u*)(o1row + dv), a2 = *(const v2u*)(o2row + dv), gg = *(const v2u*)(grow + dv);
                        const float o1v[4] = {bflo(a1[0]), bfhi(a1[0]), bflo(a1[1]), bfhi(a1[1])};
                        const float o2v[4] = {bflo(a2[0]), bfhi(a2[0]), bflo(a2[1]), bfhi(a2[1])};
                        const float gv[4] = {bflo(gg[0]), bfhi(gg[0]), bflo(gg[1]), bfhi(gg[1])};
                        float ov[4];
#pragma unroll
                        for (int e = 0; e < 4; ++e) { const float m = O[dt][4 * rq + e] * w0 + o1v[e] * w1 + o2v[e] * w2; ov[e] = m * (gv[e] / (1.f + __expf(-gv[e]))); }
                        v2u ow; ow[0] = pk2(ov[0], ov[1]); ow[1] = pk2(ov[2], ov[3]);
                        *(v2u*)(grow + dv) = ow; __builtin_amdgcn_sched_barrier(0); }
            }
        }
        __syncthreads();
    }
}

#define REP_0 1
#define REP_1 1
#define REP_2 1
#define REP_3 1
#define REP_4 1
#define REP_5 1
#define REP_6 1
#define REP_7 1
#define REP_8 1
#define REP_9 1
#define REP_10 1
#define REP_11 1
constexpr int EXTRA_SYNCS = 0;
__global__ void __launch_bounds__(NTHR, 2) yoco_fwd(Params p) {
    extern __shared__ __attribute__((aligned(16))) unsigned char lds_raw[];
    LAS unsigned char* lds = (LAS unsigned char*)lds_raw;
    cg::grid_group grid = cg::this_grid();
    const int tid = threadIdx.x, lane = tid & 63, wave = __builtin_amdgcn_readfirstlane(tid >> 6);
    const int G = gridDim.x;
    unsigned char* ws = p.ws;
    const int lo = p.ph_lo, hi = p.ph_hi;
    volatile LAS unsigned* MISC = (volatile LAS unsigned*)(lds + MISC_OFF);
    if (tid < 16) MISC[tid] = 0u;
    __syncthreads();
    XcdBarrier bar = xcd_barrier_post((unsigned*)(ws + WS_CTL), MISC + 8);
    if (hi > 1000) grid.sync();
#ifdef ONLY_PH
#define IN(k) ((k) == ONLY_PH && lo <= (k) && (k) < hi)
#else
#define IN(k) (lo <= (k) && (k) < hi)
#endif
#define SEAM(k) do { if (IN(k) && IN((k) + 1)) xcd_barrier(bar); } while (0)

#define RUN(k, ...) do { if (IN(k)) { _Pragma("unroll 1") for (int rep_ = 0; rep_ < REP_##k; ++rep_) { __VA_ARGS__; } } } while (0)
    RUN(0, p0_prologue(p, lds, tid, lane, wave, G));
    for (int xs = 0; xs < EXTRA_SYNCS; ++xs) xcd_barrier(bar);
    SEAM(0);
    RUN(1, {
        pg8::Gemm g{(const pg8::bf16_t*)(ws + WS_XB), (const pg8::bf16_t*)(ws + WS_W1T), M_TOK, 3072, 1024}; pg8::StaticOrder S; S.init(M_TOK, 3072, G, (int)blockIdx.x);
        pg8::EpiGla1 E{(pg8::bf16_t*)(ws + WS_QKVG), QSCALE};
        pg8::gemm_phase<pg8::EpiGla1, pg8::StaticOrder, true, true>(lds, g, S, E);
    });
    SEAM(1);
    RUN(2, gla_pass_a(p, lds, tid, lane, wave, G));
    SEAM(2);
    RUN(3, gla_pass_b(p, tid, G));
    SEAM(3);
    RUN(4, gla_pass_c(p, lds, tid, lane, wave, G));
    SEAM(4);
    RUN(5, {
        pg8::Gemm g{(const pg8::bf16_t*)(ws + WS_OG), (const pg8::bf16_t*)(ws + WS_W2T), M_TOK, 1024, 1024}; pg8::StaticOrder S; S.init(M_TOK, 1024, G, (int)blockIdx.x);
        pg8::EpiResid E{p.x, (float*)(ws + WS_V1), DN_ALPHA};
        pg8::gemm_phase<pg8::EpiResid, pg8::StaticOrder, true, true>(lds, g, S, E);
    });
    SEAM(5);
    RUN(6, ln_rows<true>((const float*)(ws + WS_V1), p.out, (bf16*)(ws + WS_X1B), p.ln_g, p.ln_b, lane, wave, G));
    SEAM(6);
    RUN(7, {
        pg8::Gemm g{(const pg8::bf16_t*)(ws + WS_X1B), (const pg8::bf16_t*)(ws + WS_W3T), M_TOK, 5632, 1024}; pg8::StaticOrder S; S.init(M_TOK, 5632, G, (int)blockIdx.x);
        pg8::EpiRope E{(pg8::bf16_t*)(ws + WS_K), (pg8::bf16_t*)(ws + WS_V), (pg8::bf16_t*)(ws + WS_Q), (pg8::bf16_t*)(ws + WS_G), (const float*)(ws + WS_COS), (const float*)(ws + WS_SIN), QSCALE};
        pg8::gemm_phase<pg8::EpiRope, pg8::StaticOrder, true, true>(lds, g, S, E);
    });
    SEAM(7);
    RUN(8, attn_phase<false>(p, lds, tid, lane, wave, G));
    SEAM(8);
    RUN(9, attn_phase<true>(p, lds, tid, lane, wave, G));
    SEAM(9);
    RUN(10, {
        pg8::Gemm g{(const pg8::bf16_t*)(ws + WS_G), (const pg8::bf16_t*)(ws + WS_W4T), M_TOK, 1024, 1024}; pg8::StaticOrder S; S.init(M_TOK, 1024, G, (int)blockIdx.x);
        pg8::EpiResid E{p.out, (float*)(ws + WS_V1), DN_ALPHA};
        pg8::gemm_phase<pg8::EpiResid, pg8::StaticOrder, true, true>(lds, g, S, E);
    });
    SEAM(10);
    RUN(11, ln_rows<false>((const float*)(ws + WS_V1), p.out, (bf16*)nullptr, p.ln_g + DM, p.ln_b + DM, lane, wave, G));
#undef RUN
#undef IN
#undef SEAM
}

#ifndef N_LAUNCH_SPLIT
#define N_LAUNCH_SPLIT 0
#endif
extern "C" void kernel_launch(void* const* d_in, const int* in_sizes, int n_in, void* d_out, int out_size, void* d_ws, size_t ws_size, hipStream_t stream) {
    static int grid = 0;
    if (grid == 0) {
        int dev = 0, cus = 0, per_cu = 0;
        hipGetDevice(&dev);
        hipDeviceGetAttribute(&cus, hipDeviceAttributeMultiprocessorCount, dev);
        hipFuncSetAttribute((const void*)yoco_fwd, hipFuncAttributeMaxDynamicSharedMemorySize, LDS_BYTES);
        hipOccupancyMaxActiveBlocksPerMultiprocessor(&per_cu, (const void*)yoco_fwd, NTHR, LDS_BYTES);
        if (per_cu < 1) { fprintf(stderr, "kernel_launch: occupancy query says %d blocks/CU\n", per_cu); per_cu = 1; }
        grid = cus * per_cu;
        (void)hipGetLastError();
    }
    if (hipMemsetAsync((char*)d_ws + WS_CTL, 0, CTL_ZERO_BYTES, stream) != hipSuccess) { fprintf(stderr, "kernel_launch: memset of control words failed\n"); return; }
    Params p;
    memset(&p, 0, sizeof(p));
    p.x = (const float*)d_in[0]; p.gla_w_in = (const float*)d_in[1]; p.gla_w_a2 = (const float*)d_in[2]; p.gla_b_a2 = (const float*)d_in[3];
    p.gla_norm_g = (const float*)d_in[4]; p.gla_w_out = (const float*)d_in[5]; p.w_kv = (const float*)d_in[6]; p.swa_w_in = (const float*)d_in[7];
    p.swa_w_out = (const float*)d_in[8]; p.ln_g = (const float*)d_in[9]; p.ln_b = (const float*)d_in[10];
    p.out = (float*)d_out; p.ws = (unsigned char*)d_ws;
    for (int i = 0; i < 64; ++i) p.inv_freq[i] = powf(10000.0f, -((float)i * 2.0f) / 128.0f);
#if N_LAUNCH_SPLIT
    for (int ph = 0; ph < 12; ++ph) { p.ph_lo = ph; p.ph_hi = ph + 1; hipLaunchKernelGGL(yoco_fwd, dim3(grid), dim3(NTHR), LDS_BYTES, stream, p); }
#else
    p.ph_lo = 0; p.ph_hi = 12;
    void* args[] = {&p};
    hipError_t e = hipLaunchCooperativeKernel((const void*)yoco_fwd, dim3(grid), dim3(NTHR), args, LDS_BYTES, stream);
    if (e != hipSuccess) fprintf(stderr, "cooperative launch failed: %s (grid %d)\n", hipGetErrorString(e), grid);
#endif
}
```
